# Optimizing an MI355X kernel written in HIP

```python
import math
import jax, jax.numpy as jnp
from jax import lax
import numpy as np

D_MODEL = 1024
BATCH = 16
SEQ = 4096
DEPTH = 2

N_MIXERS = 2
HEAD_DIM = 64
ROPE_THETA = 500000.0
ROT_DIM = HEAD_DIM // 4

DIL_GROUPS = ((128, 1), (512, 4), (2048, 16))
DIL_HEADS = 4
N_DIL_HEADS = len(DIL_GROUPS) * DIL_HEADS
DIL_WIDTH = N_DIL_HEADS * HEAD_DIM
WIN_BLOCK = 64

MEM_LEN = 256
MEM_HEADS = 4
MEM_WIDTH = MEM_HEADS * HEAD_DIM

MLA_HEADS = 8
MLA_NOPE = 64
MLA_ROPE = 32
MLA_V = 64
Q_LORA = 256
KV_LORA = 128
MLA_Q_BLOCK = 128

N_GROUPS = 4
EXPERTS_PER_GROUP = 8
N_EXPERTS = N_GROUPS * EXPERTS_PER_GROUP
TOP_K = 2
D_EXPERT = 512
MOE_BLOCK = 128

LN_EPS = 1e-5
RMS_EPS = 1e-6
NEG_INF = -1e30
ALPHA = (2 * DEPTH) ** 0.25
BETA = (8 * DEPTH) ** -0.25
N_A_LAYERS = (DEPTH + 1) // 2
N_B_LAYERS = DEPTH // 2

A_IN_WIDTH = 3 * DIL_WIDTH + MEM_WIDTH
B_IN_WIDTH = Q_LORA + KV_LORA + MLA_ROPE + MEM_WIDTH
A_OUT_IN = DIL_HEADS * HEAD_DIM + MEM_WIDTH
B_OUT_IN = MLA_HEADS * MLA_V + MEM_WIDTH

kernel_name = "hybrid_dilated_mla_hmoe_encoder"


def layer_norm(x, g, b):
    xf = x.astype(jnp.float32)
    mu = xf.mean(-1, keepdims=True)
    var = jnp.square(xf - mu).mean(-1, keepdims=True)
    return ((xf - mu) * lax.rsqrt(var + LN_EPS) * g + b).astype(x.dtype)


def rms_norm(x, g):
    xf = x.astype(jnp.float32)
    return (xf * lax.rsqrt(jnp.square(xf).mean(-1, keepdims=True) + RMS_EPS) * g).astype(x.dtype)


def rope_tables(seq, dim):
    inv = ROPE_THETA ** (-jnp.arange(0, dim, 2, dtype=jnp.float32) / dim)
    ang = jnp.arange(seq, dtype=jnp.float32)[:, None] * inv[None, :]
    return jnp.cos(ang), jnp.sin(ang)


def apply_rope(t, cos, sin):
    half = t.shape[-1] // 2
    tf = t.astype(jnp.float32)
    t1, t2 = tf[..., :half], tf[..., half:]
    c, s = cos[None, :, None, :], sin[None, :, None, :]
    return jnp.concatenate([t1 * c - t2 * s, t2 * c + t1 * s], -1).astype(t.dtype)


def partial_rope(t, cos, sin):
    return jnp.concatenate([apply_rope(t[..., :ROT_DIM], cos, sin), t[..., ROT_DIM:]], -1)


def banded_attention(q, k, v, radius):
    n, L, h, dh = q.shape
    blk = WIN_BLOCK
    nb = -(-L // blk)
    Lp = nb * blk
    qb = jnp.pad(q, ((0, 0), (0, Lp - L), (0, 0), (0, 0))).reshape(n, nb, blk, h, dh)
    kv_pad = ((0, 0), (blk, Lp - L + blk), (0, 0), (0, 0))
    kp = jnp.pad(k, kv_pad).reshape(n, nb + 2, blk, h, dh)
    vp = jnp.pad(v, kv_pad).reshape(n, nb + 2, blk, h, dh)
    kw = jnp.concatenate([kp[:, :-2], kp[:, 1:-1], kp[:, 2:]], axis=2)
    vw = jnp.concatenate([vp[:, :-2], vp[:, 1:-1], vp[:, 2:]], axis=2)
    qpos = jnp.arange(nb)[:, None] * blk + jnp.arange(blk)[None, :]
    kpos = jnp.arange(nb)[:, None] * blk - blk + jnp.arange(3 * blk)[None, :]
    mask = ((jnp.abs(qpos[:, :, None] - kpos[:, None, :]) <= radius)
            & (kpos[:, None, :] >= 0) & (kpos[:, None, :] < L))
    s = jnp.einsum('nbqhd,nbkhd->nbhqk', qb, kw, preferred_element_type=jnp.float32) * (dh ** -0.5)
    s = jnp.where(mask[None, :, None], s, NEG_INF)
    lse = jax.nn.logsumexp(s, axis=-1)
    p = jnp.exp(s - lse[..., None])
    o = jnp.einsum('nbhqk,nbkhd->nbqhd', p.astype(v.dtype), vw)
    o = o.reshape(n, Lp, h, dh)[:, :L]
    lse = lse.transpose(0, 1, 3, 2).reshape(n, Lp, h)[:, :L]
    return o, lse


def dilated_mixer(q, k, v):
    B, S = q.shape[0], q.shape[1]
    outs, lses = [], []
    for g, (window, dil) in enumerate(DIL_GROUPS):
        sl = slice(g * DIL_HEADS, (g + 1) * DIL_HEADS)
        T = S // dil
        radius = window // (2 * dil)

        def to_sub(t):
            return t[:, :, sl].reshape(B, T, dil, DIL_HEADS, HEAD_DIM).transpose(0, 2, 1, 3, 4).reshape(B * dil, T, DIL_HEADS, HEAD_DIM)

        o, lse = banded_attention(to_sub(q), to_sub(k), to_sub(v), radius)
        outs.append(o.reshape(B, dil, T, DIL_HEADS, HEAD_DIM).transpose(0, 2, 1, 3, 4).reshape(B, S, DIL_HEADS, HEAD_DIM))
        lses.append(lse.reshape(B, dil, T, DIL_HEADS).transpose(0, 2, 1, 3).reshape(B, S, DIL_HEADS))
    w = jax.nn.softmax(jnp.stack(lses), axis=0)
    return jnp.einsum('gbsh,gbshd->bshd', w.astype(q.dtype), jnp.stack(outs))


def mla_mixer(c_q, c_kv, k_rope, q_norm_g, w_qb, kv_norm_g, w_kvb, cos, sin):
    B, S = c_q.shape[0], c_q.shape[1]
    q = (rms_norm(c_q, q_norm_g) @ w_qb).reshape(B, S, MLA_HEADS, MLA_NOPE + MLA_ROPE)
    q_nope = q[..., :MLA_NOPE]
    q_pe = apply_rope(q[..., MLA_NOPE:], cos, sin)
    kv = (rms_norm(c_kv, kv_norm_g) @ w_kvb).reshape(B, S, MLA_HEADS, MLA_NOPE + MLA_V)
    k_nope, v = kv[..., :MLA_NOPE], kv[..., MLA_NOPE:]
    k_pe = apply_rope(k_rope[:, :, None, :], cos, sin)[:, :, 0]
    scale = (MLA_NOPE + MLA_ROPE) ** -0.5
    nq = S // MLA_Q_BLOCK
    qn_b = q_nope.reshape(B, nq, MLA_Q_BLOCK, MLA_HEADS, MLA_NOPE).transpose(1, 0, 2, 3, 4)
    qp_b = q_pe.reshape(B, nq, MLA_Q_BLOCK, MLA_HEADS, MLA_ROPE).transpose(1, 0, 2, 3, 4)

    def one_block(args):
        qn, qp = args
        s = (jnp.einsum('bqhd,bkhd->bhqk', qn, k_nope, preferred_element_type=jnp.float32)
             + jnp.einsum('bqhr,bkr->bhqk', qp, k_pe, preferred_element_type=jnp.float32)) * scale
        p = jax.nn.softmax(s, axis=-1)
        return jnp.einsum('bhqk,bkhd->bqhd', p.astype(v.dtype), v)

    o = lax.map(one_block, (qn_b, qp_b))
    return o.transpose(1, 0, 2, 3, 4).reshape(B, S, MLA_HEADS, MLA_V)


def memory_attention(q, mem, w_kv):
    B, M = mem.shape[0], mem.shape[1]
    kv = (mem @ w_kv).reshape(B, M, 2, MEM_HEADS, HEAD_DIM)
    k, v = kv[:, :, 0], kv[:, :, 1]
    s = jnp.einsum('bshd,bmhd->bhsm', q, k, preferred_element_type=jnp.float32) * (HEAD_DIM ** -0.5)
    p = jax.nn.softmax(s, axis=-1)
    return jnp.einsum('bhsm,bmhd->bshd', p.astype(v.dtype), v)


def hierarchical_moe(x, w_grp, b_grp, w_exp_router, b_exp, w_gate, w_up, w_down):
    B, S, D = x.shape
    xt = x.reshape(-1, D)
    n = xt.shape[0]
    grp_logits = (xt @ w_grp).astype(jnp.float32) + b_grp
    g_idx = jnp.argmax(grp_logits, axis=-1)
    g_gate = jnp.take_along_axis(jax.nn.softmax(grp_logits, axis=-1), g_idx[:, None], axis=-1)
    exp_logits = ((xt @ w_exp_router).astype(jnp.float32) + b_exp).reshape(n, N_GROUPS, EXPERTS_PER_GROUP)
    in_grp = jnp.take_along_axis(exp_logits, g_idx[:, None, None], axis=1)[:, 0]
    top_v, top_i = lax.top_k(in_grp, TOP_K)
    gates = jax.nn.softmax(top_v, axis=-1) * g_gate
    eid = (g_idx[:, None] * EXPERTS_PER_GROUP + top_i).reshape(-1).astype(jnp.int32)
    a = n * TOP_K
    tok = jnp.arange(a, dtype=jnp.int32) // TOP_K
    gw = gates.reshape(-1)
    order = jnp.argsort(eid)
    eid_s, tok_s, gw_s = eid[order], tok[order], gw[order]
    counts = jnp.zeros((N_EXPERTS,), jnp.int32).at[eid].add(1)
    starts = jnp.cumsum(counts) - counts
    padded = (counts + MOE_BLOCK - 1) // MOE_BLOCK * MOE_BLOCK
    pends = jnp.cumsum(padded)
    pstarts = pends - padded
    dest = pstarts[eid_s] + (jnp.arange(a, dtype=jnp.int32) - starts[eid_s])
    n_slots = (-(-a // MOE_BLOCK) + N_EXPERTS) * MOE_BLOCK
    n_blocks = n_slots // MOE_BLOCK
    slot_tok = jnp.zeros((n_slots,), jnp.int32).at[dest].set(tok_s)
    slot_w = jnp.zeros((n_slots,), jnp.float32).at[dest].set(gw_s)
    blk_expert = jnp.minimum(jnp.searchsorted(pends, jnp.arange(n_blocks, dtype=jnp.int32) * MOE_BLOCK, side='right'), N_EXPERTS - 1)
    xs = xt[slot_tok].reshape(n_blocks, MOE_BLOCK, D)

    def expert_block(args):
        xb, e = args
        h = jax.nn.silu(xb @ w_gate[e]) * (xb @ w_up[e])
        return h @ w_down[e]

    ys = lax.map(expert_block, (xs, blk_expert)).reshape(n_slots, D)
    out = jax.ops.segment_sum(ys * slot_w[:, None].astype(ys.dtype), slot_tok, num_segments=n)
    return out.reshape(B, S, D)


def setup_inputs(seed: int = 0) -> dict:
    key = jax.random.key(seed)
    ks = iter(jax.random.split(key, 32))

    def nrm(shape, scale):
        return jax.random.normal(next(ks), shape, jnp.float32) * scale

    D = D_MODEL
    return {
        "x": nrm((BATCH, SEQ, D), 1.0),
        "mem": nrm((BATCH, MEM_LEN, D), 1.0),
        "a_w_in": nrm((N_A_LAYERS, D, A_IN_WIDTH), D ** -0.5),
        "a_w_out": nrm((N_A_LAYERS, A_OUT_IN, D), A_OUT_IN ** -0.5 * BETA),
        "b_w_in": nrm((N_B_LAYERS, D, B_IN_WIDTH), D ** -0.5),
        "b_q_norm": 1.0 + nrm((N_B_LAYERS, Q_LORA), 0.02),
        "b_w_qb": nrm((N_B_LAYERS, Q_LORA, MLA_HEADS * (MLA_NOPE + MLA_ROPE)), Q_LORA ** -0.5),
        "b_kv_norm": 1.0 + nrm((N_B_LAYERS, KV_LORA), 0.02),
        "b_w_kvb": nrm((N_B_LAYERS, KV_LORA, MLA_HEADS * (MLA_NOPE + MLA_V)), KV_LORA ** -0.5),
        "b_w_out": nrm((N_B_LAYERS, B_OUT_IN, D), B_OUT_IN ** -0.5 * BETA),
        "mem_w_kv": nrm((DEPTH, D, 2 * MEM_WIDTH), D ** -0.5),
        "ln_mix_g": 1.0 + nrm((DEPTH, D), 0.02),
        "ln_mix_b": nrm((DEPTH, D), 0.02),
        "ln_ffn_g": 1.0 + nrm((DEPTH, D), 0.02),
        "ln_ffn_b": nrm((DEPTH, D), 0.02),
        "router_w_grp": nrm((DEPTH, D, N_GROUPS), D ** -0.5),
        "router_b_grp": nrm((DEPTH, N_GROUPS), 0.01),
        "router_w_exp": nrm((DEPTH, D, N_EXPERTS), D ** -0.5),
        "router_b_exp": nrm((DEPTH, N_EXPERTS), 0.01),
        "exp_w_gate": nrm((DEPTH, N_EXPERTS, D, D_EXPERT), D ** -0.5),
        "exp_w_up": nrm((DEPTH, N_EXPERTS, D, D_EXPERT), D ** -0.5),
        "exp_w_down": nrm((DEPTH, N_EXPERTS, D_EXPERT, D), D_EXPERT ** -0.5 * BETA),
    }


def reference(x, mem, a_w_in, a_w_out, b_w_in, b_q_norm, b_w_qb, b_kv_norm, b_w_kvb, b_w_out,
              mem_w_kv, ln_mix_g, ln_mix_b, ln_ffn_g, ln_ffn_b, router_w_grp, router_b_grp,
              router_w_exp, router_b_exp, exp_w_gate, exp_w_up, exp_w_down):
    B, S, _ = x.shape
    cos_a, sin_a = rope_tables(S, ROT_DIM)
    cos_b, sin_b = rope_tables(S, MLA_ROPE)
    for i in range(DEPTH):
        j = i // N_MIXERS
        if i % N_MIXERS == 0:
            proj = x @ a_w_in[j]
            q, k, v, qm = jnp.split(proj, [DIL_WIDTH, 2 * DIL_WIDTH, 3 * DIL_WIDTH], axis=-1)
            q = partial_rope(q.reshape(B, S, N_DIL_HEADS, HEAD_DIM), cos_a, sin_a)
            k = partial_rope(k.reshape(B, S, N_DIL_HEADS, HEAD_DIM), cos_a, sin_a)
            v = v.reshape(B, S, N_DIL_HEADS, HEAD_DIM)
            mix = dilated_mixer(q, k, v).reshape(B, S, DIL_HEADS * HEAD_DIM)
            w_out = a_w_out[j]
        else:
            proj = x @ b_w_in[j]
            c_q, c_kv, k_rope, qm = jnp.split(proj, [Q_LORA, Q_LORA + KV_LORA, Q_LORA + KV_LORA + MLA_ROPE], axis=-1)
            mix = mla_mixer(c_q, c_kv, k_rope, b_q_norm[j], b_w_qb[j], b_kv_norm[j], b_w_kvb[j],
                            cos_b, sin_b).reshape(B, S, MLA_HEADS * MLA_V)
            w_out = b_w_out[j]
        mo = memory_attention(qm.reshape(B, S, MEM_HEADS, HEAD_DIM), mem, mem_w_kv[i]).reshape(B, S, MEM_WIDTH)
        y = jnp.concatenate([mix, mo], axis=-1) @ w_out
        x = layer_norm(ALPHA * x + y, ln_mix_g[i], ln_mix_b[i])
        f = hierarchical_moe(x, router_w_grp[i], router_b_grp[i], router_w_exp[i], router_b_exp[i],
                             exp_w_gate[i], exp_w_up[i], exp_w_down[i])
        x = layer_norm(ALPHA * x + f, ln_ffn_g[i], ln_ffn_b[i])
    return x
```

```cpp
#include <hip/hip_runtime.h>
#include <cstdio>
#include <cstdint>

#ifndef MK_N_LAUNCHES
#define MK_N_LAUNCHES 1
#endif

#define LAS __attribute__((address_space(3)))
#define GAS __attribute__((address_space(1)))
typedef unsigned short bf16_t;
typedef short bf16x8 __attribute__((ext_vector_type(8)));
typedef short s16x4 __attribute__((ext_vector_type(4)));
typedef float f32x2 __attribute__((ext_vector_type(2)));
typedef float f32x4 __attribute__((ext_vector_type(4)));
typedef float f32x16 __attribute__((ext_vector_type(16)));
typedef unsigned u32x2 __attribute__((ext_vector_type(2)));
typedef unsigned u32x4 __attribute__((ext_vector_type(4)));
typedef __bf16 bf16x2_t __attribute__((ext_vector_type(2)));

constexpr int DM = 1024, NB = 16, SEQ = 4096, NTOK = NB * SEQ, MEML = 256, NMEM = NB * MEML;
constexpr int A_IN = 2560, B_IN = 672, B_INP = 768;
constexpr int NEXP = 32, DEXP = 512, MAXTILES = 544, MAXSLOTS = MAXTILES * 256;
constexpr float LN_EPS = 1e-5f, RMS_EPS = 1e-6f, ALPHA = 1.41421356237309515f;
constexpr float LOG2E = 1.4426950408889634f;
constexpr float C2_64 = 0.125f * LOG2E;
constexpr float C2_96 = 0.10206207261596575f * LOG2E;
constexpr int NWAVES = 8, NTHREADS = 512;

constexpr size_t MiB = 1u << 20;
constexpr size_t WS_CTL = 0, CTL_ZERO_BYTES = 1 * MiB;
constexpr size_t WS_ROPEA = 1 * MiB;
constexpr size_t WS_ROPEB = 1 * MiB + 256 * 1024;
constexpr size_t WS_WGCNT = 1 * MiB + 768 * 1024;
constexpr size_t WS_META  = WS_WGCNT + 64 * 1024;
constexpr size_t WS_RQ = 2 * MiB, WS_RKV = 3 * MiB;
constexpr size_t WS_WINA = 4 * MiB, WS_WOUTA = 9 * MiB, WS_WINB = 10 * MiB, WS_WQB = 11 * MiB + 512 * 1024, WS_WKVB = 12 * MiB,
                 WS_WOUTB = 12 * MiB + 512 * 1024, WS_WMEM = 14 * MiB, WS_WR = 16 * MiB;
constexpr size_t WS_WGU = 17 * MiB, WS_WD = 145 * MiB;
constexpr size_t WS_MEMB = 209 * MiB, WS_MEMKV = 217 * MiB;
constexpr size_t WS_TOKSLOT = 225 * MiB, WS_TOKGW = WS_TOKSLOT + 512 * 1024, WS_TOKEID = WS_TOKGW + 512 * 1024, WS_SLOTTOK = WS_TOKEID + 512 * 1024;
constexpr size_t WS_X = 228 * MiB;
constexpr size_t WS_R1 = 356 * MiB, WS_R2 = 676 * MiB;
constexpr size_t WS_PROJ = WS_R1;
constexpr size_t WS_OG = WS_R2, WS_LSE = WS_R2 + 96 * MiB, WS_CAT = WS_R2 + 100 * MiB, WS_Y = WS_R2 + 164 * MiB;
constexpr size_t WS_H = WS_R1, WS_YS = WS_R2;
constexpr size_t WS_PROJB = WS_R1, WS_QB = WS_R1 + 96 * MiB, WS_ATT = WS_R1 + 192 * MiB, WS_KV = WS_R2;
constexpr size_t WS_XB = WS_R1 + 192 * MiB;
constexpr size_t WS_END = 1024 * MiB;
static_assert(WS_SLOTTOK + (size_t)MAXSLOTS * 4 <= WS_X, "map");
static_assert(WS_CAT + (size_t)NTOK * 512 * 2 <= WS_Y && WS_Y + (size_t)NTOK * 1024 * 2 <= WS_END, "map");
static_assert(WS_YS + (size_t)MAXSLOTS * 1024 * 2 <= WS_END && WS_H + (size_t)MAXSLOTS * 512 * 2 <= WS_R2, "map");
static_assert(WS_ATT + (size_t)NTOK * 768 * 2 <= WS_R2 && WS_KV + (size_t)NTOK * 1024 * 2 <= WS_Y, "map");
constexpr int CW_TMO = 0, CW_BAR = 4096, CW_DIAG = 32768;

constexpr int RING_BYTES = 131072;
constexpr int MISC_OFF = RING_BYTES;
constexpr int LDS_BYTES = 147456;

#define LDS_WAIT() asm volatile("s_waitcnt lgkmcnt(0)" ::: "memory")
#define VM_WAIT() asm volatile("s_waitcnt vmcnt(0)" ::: "memory")
__device__ __forceinline__ unsigned pk2(float lo, float hi) { f32x2 v = {lo, hi}; bf16x2_t b = __builtin_convertvector(v, bf16x2_t); return __builtin_bit_cast(unsigned, b); }
__device__ __forceinline__ float bf2f(unsigned short b) { return __uint_as_float(((unsigned)b) << 16); }
__device__ __forceinline__ float bflo(unsigned w) { return __uint_as_float(w << 16); }
__device__ __forceinline__ float bfhi(unsigned w) { return __uint_as_float(w & 0xffff0000u); }
__device__ __forceinline__ float wave_sum(float v) {
#pragma unroll
    for (int o = 1; o < 64; o <<= 1) v += __shfl_xor(v, o);
    return v;
}

#define XB_TMO      128
#define XB_XCNT(j)  (256  + 64 * (j))
#define XB_XSUB(j)  (1280 + 64 * (j))
#define XB_XGEN(j)  (2304 + 64 * (j))
#define XB_TOP      3328
#define XB_TOPGEN   3392
#define XCD_BAR_WORDS 3456
#define XB_SPIN_CAP (1u << 24)
__device__ __forceinline__ unsigned xb_ld(unsigned* p)              { return __hip_atomic_load(p, __ATOMIC_RELAXED, __HIP_MEMORY_SCOPE_AGENT); }
__device__ __forceinline__ unsigned xb_add(unsigned* p, unsigned v) { return __hip_atomic_fetch_add(p, v, __ATOMIC_RELAXED, __HIP_MEMORY_SCOPE_AGENT); }
__device__ __forceinline__ unsigned xb_xcc_id() { return (unsigned)__builtin_amdgcn_s_getreg((3 << 11) | 20) & 0xFu; }
#define XB_SPIN(cond, bar) do { unsigned _sp = 0; while (cond) { __builtin_amdgcn_s_sleep(1); \
    if ((++_sp & 255u) == 0u) { if (xb_ld(&(bar)[XB_TMO])) break; if (_sp > XB_SPIN_CAP) { atomicAdd(&(bar)[XB_TMO], 1u); break; } } } } while (0)
struct XcdBarrier { unsigned* bar; unsigned x; volatile LAS unsigned* st; };
__device__ __forceinline__ XcdBarrier xcd_barrier_post(unsigned* bar, volatile LAS unsigned* st) {
    XcdBarrier b; b.bar = bar; b.x = xb_xcc_id(); b.st = st;
    if (threadIdx.x == 0) (void)xb_add(&bar[XB_XCNT(b.x)], 1u);
    return b;
}
__device__ __forceinline__ void xcd_barrier_complete(unsigned* bar, unsigned x, unsigned& nloc, unsigned& nx) {
    const unsigned G = gridDim.x * gridDim.y * gridDim.z;
    unsigned sum, cnt, mine, sp = 0u;
    for (;;) {
        sum = 0u; cnt = 0u; mine = 0u;
#pragma unroll
        for (unsigned j = 0; j < 16; ++j) { const unsigned c = xb_ld(&bar[XB_XCNT(j)]); sum += c; cnt += (c > 0u) ? 1u : 0u; mine = (j == x) ? c : mine; }
        if (sum == G) break;
        __builtin_amdgcn_s_sleep(1);
        if ((++sp & 255u) == 0u) { if (xb_ld(&bar[XB_TMO])) break; if (sp > XB_SPIN_CAP) { atomicAdd(&bar[XB_TMO], 1u); break; } }
    }
    nloc = mine > 0u ? mine : 1u; nx = cnt > 0u ? cnt : 1u;
}
__device__ __forceinline__ void xcd_barrier(const XcdBarrier& b) {
    asm volatile("s_waitcnt vmcnt(0)" ::: "memory");
    __syncthreads();
    if (threadIdx.x == 0) {
        unsigned* bar = b.bar;
        __builtin_amdgcn_s_waitcnt(0);
        unsigned nloc = b.st[0], nx = b.st[1];
        if (nloc == 0u) { xcd_barrier_complete(bar, b.x, nloc, nx); b.st[0] = nloc; b.st[1] = nx; }
        const unsigned old = xb_add(&bar[XB_XSUB(b.x)], 1u);
        const unsigned gen = old / nloc;
        if (old + 1u == (gen + 1u) * nloc) {
            __builtin_amdgcn_fence(__ATOMIC_RELEASE, "agent");
            asm volatile("s_waitcnt vmcnt(0)" ::: "memory");
            const unsigned og = xb_add(&bar[XB_TOP], 1u);
            const unsigned tg = og / nx;
            if (og + 1u == (tg + 1u) * nx) xb_add(&bar[XB_TOPGEN], 1u);
            else XB_SPIN(xb_ld(&bar[XB_TOPGEN]) == tg, bar);
            __builtin_amdgcn_fence(__ATOMIC_ACQUIRE, "agent");
            xb_add(&bar[XB_XGEN(b.x)], 1u);
            asm volatile("s_waitcnt vmcnt(0)" ::: "memory");
        } else {
            XB_SPIN(xb_ld(&bar[XB_XGEN(b.x)]) == gen, bar);
            __builtin_amdgcn_fence(__ATOMIC_ACQUIRE, "agent");
            asm volatile("s_waitcnt vmcnt(0)" ::: "memory");
        }
    }
    __syncthreads();
}

namespace pg {
constexpr int BM = 256, BK = 64, HALF = 128, HTB = HALF * BK * 2, NXCD = 8, WGM = 8;
__device__ __forceinline__ int lds_byte(int r, int c) { const int st = (r >> 4) * 2 + (c >> 5), rr = r & 15, cc = c & 31, ob = rr * 64 + cc * 2; return st * 1024 + (ob ^ (((ob >> 9) & 1) << 5)); }
__device__ __forceinline__ void stage_rc(int b, int& R, int& C) { const int st = b / 1024, sb = b % 1024, swz = sb ^ (((sb >> 9) & 1) << 5); R = (st >> 1) * 16 + swz / 64; C = (st & 1) * 32 + (swz % 64) / 2; }
__device__ __forceinline__ bool static_order(int i, int G, int c, int nM, int nN, int& pm, int& pn) {
    const int nwg = nM * nN; const long L = (long)i * G + c; if (L >= nwg) return false;
    int wgid = (int)L; { const int q = nwg / NXCD, r = nwg % NXCD, xcd = wgid % NXCD, off = wgid / NXCD; wgid = (xcd < r ? xcd * (q + 1) : r * (q + 1) + (xcd - r) * q) + off; }
    const int nig = WGM * nN, gid = wgid / nig, fm = gid * WGM, gsz = (nM - fm) < WGM ? (nM - fm) : WGM;
    pm = fm + ((wgid % nig) % gsz); pn = (wgid % nig) / gsz; return true;
}

template <class Prob, class Epi>
__device__ __forceinline__ void gemm_phase(LAS unsigned char* lds, const Prob& P, const Epi& E) {
    typedef typename Prob::Unit Unit;
    const int tid = threadIdx.x, wid = __builtin_amdgcn_readfirstlane(tid >> 6), lane = tid & 63, wr = wid >> 2, wc = wid & 3, fr = lane & 15, fq = lane >> 4;
    const int nt = P.K / BK;
    int Rr[2]; unsigned Cb[2], voffB[2];
#pragma unroll
    for (int i = 0; i < 2; ++i) { int R, C; stage_rc(tid * 16 + i * 8192, R, C); Rr[i] = R; Cb[i] = (unsigned)C * 2u; voffB[i] = (unsigned)R * P.ldb_bytes + (unsigned)C * 2u; }
    const size_t kstep = (size_t)(BK * 2);
    const size_t hstepB = (size_t)HALF * P.ldb_bytes;
    const unsigned ldsw = (unsigned)wid * 1024u;
    const int aoff = lds_byte(wr * 64 + fr, fq * 8), boff = lds_byte(wc * 32 + fr, fq * 8);
    const char* const Abase = P.Abase;
#define PG_SA(b, h) (((b) * 2 + (h)) * HTB)
#define PG_SB(b, h) ((4 + (b) * 2 + (h)) * HTB)
#define PG_STAGE(bufoff, gbase, voff) do { _Pragma("unroll") for (int _i = 0; _i < 2; ++_i) \
        __builtin_amdgcn_global_load_lds((const unsigned*)((const char*)(gbase) + (voff)[_i]), (LAS unsigned*)(lds + (bufoff) + ldsw + _i * 8192), 16, 0, 0); } while (0)
#define PG_LDA(dst, b, h) do { _Pragma("unroll") for (int m = 0; m < 4; ++m) _Pragma("unroll") for (int k = 0; k < 2; ++k) dst[m][k] = *(const LAS bf16x8*)(lds + PG_SA(b, h) + aoff + m * 2048 + k * 1024); } while (0)
#define PG_LDB(dst, b, h) do { _Pragma("unroll") for (int n = 0; n < 2; ++n) _Pragma("unroll") for (int k = 0; k < 2; ++k) dst[n][k] = *(const LAS bf16x8*)(lds + PG_SB(b, h) + boff + n * 2048 + k * 1024); } while (0)
#define PG_MMA(ai, bj, At, Bt) do { __builtin_amdgcn_s_setprio(1); _Pragma("unroll") for (int m = 0; m < 4; ++m) _Pragma("unroll") for (int n = 0; n < 2; ++n) _Pragma("unroll") for (int k = 0; k < 2; ++k) \
        acc[ai][bj][m][n] = __builtin_amdgcn_mfma_f32_16x16x32_bf16(Bt[n][k], At[m][k], acc[ai][bj][m][n], 0, 0, 0); __builtin_amdgcn_s_setprio(0); } while (0)
#define PG_WAIT_V(n) asm volatile("s_waitcnt vmcnt(" #n ")" ::: "memory")
#define PG_WAIT_L(n) asm volatile("s_waitcnt lgkmcnt(" #n ")" ::: "memory")
#define PG_BAR __builtin_amdgcn_s_barrier()
#define PG_SCHED __builtin_amdgcn_sched_barrier(0)
    Unit cur, nxt; int ui = 0;
    if (!P.next(0, cur)) return;
    f32x4 acc[2][2][4][2];
#pragma unroll
    for (int a = 0; a < 2; ++a)
#pragma unroll
        for (int b = 0; b < 2; ++b)
#pragma unroll
            for (int m = 0; m < 4; ++m)
#pragma unroll
                for (int n = 0; n < 2; ++n) acc[a][b][m][n] = (f32x4){0.f, 0.f, 0.f, 0.f};
    bf16x8 At[4][2], B0[2][2], B1[2][2];
    unsigned aC0[2], aC1[2], aN0[2], aN1[2];
#pragma unroll
    for (int i = 0; i < 2; ++i) { aC0[i] = (unsigned)P.arow(cur, Rr[i]) * P.lda_bytes + Cb[i]; aC1[i] = (unsigned)P.arow(cur, Rr[i] + HALF) * P.lda_bytes + Cb[i]; }
    const char* cB = P.bbase(cur);
    PG_STAGE(PG_SB(0, 0), cB, voffB); PG_STAGE(PG_SB(0, 1), cB + hstepB, voffB); PG_STAGE(PG_SA(0, 0), Abase, aC0); PG_STAGE(PG_SA(0, 1), Abase, aC1);
    if (wr == 1) PG_BAR;
    PG_WAIT_V(2); PG_BAR;
    PG_STAGE(PG_SB(1, 0), cB + kstep, voffB); PG_STAGE(PG_SA(1, 0), Abase + kstep, aC0); PG_STAGE(PG_SB(1, 1), cB + hstepB + kstep, voffB);
    PG_WAIT_V(6); PG_BAR;
    for (;;) {
        const bool has_next = P.next(ui + 1, nxt);
        const char* nB = cB;
#pragma unroll
        for (int i = 0; i < 2; ++i) { aN0[i] = aC0[i]; aN1[i] = aC1[i]; }
        if (has_next) { nB = P.bbase(nxt);
#pragma unroll
            for (int i = 0; i < 2; ++i) { aN0[i] = (unsigned)P.arow(nxt, Rr[i]) * P.lda_bytes + Cb[i]; aN1[i] = (unsigned)P.arow(nxt, Rr[i] + HALF) * P.lda_bytes + Cb[i]; } }
        for (int t = 0; t < nt; t += 2) {
            const bool last = (t == nt - 2);
            const char* a1 = Abase + (size_t)(t + 1) * kstep;
            const char* a2 = last ? Abase : Abase + (size_t)(t + 2) * kstep; const char* b2 = last ? nB : cB + (size_t)(t + 2) * kstep;
            const char* a3 = a2 + kstep; const char* b3 = b2 + kstep;
            unsigned aS0[2], aS1[2];
#pragma unroll
            for (int i = 0; i < 2; ++i) { aS0[i] = last ? aN0[i] : aC0[i]; aS1[i] = last ? aN1[i] : aC1[i]; }
            PG_LDB(B0, 0, 0); PG_LDB(B1, 0, 1); PG_SCHED; PG_LDA(At, 0, 0); PG_STAGE(PG_SA(1, 1), a1, aC1);
            PG_WAIT_V(8); PG_WAIT_L(0); PG_BAR; PG_MMA(0, 0, At, B0); PG_MMA(0, 1, At, B1); PG_BAR; PG_SCHED;
            PG_LDA(At, 0, 1); PG_STAGE(PG_SB(0, 0), b2, voffB); PG_STAGE(PG_SB(0, 1), b2 + hstepB, voffB); PG_STAGE(PG_SA(0, 0), a2, aS0);
            PG_WAIT_V(8); PG_WAIT_L(0); PG_BAR; PG_MMA(1, 0, At, B0); PG_MMA(1, 1, At, B1); PG_BAR; PG_SCHED;
            PG_LDB(B0, 1, 0); PG_LDB(B1, 1, 1); PG_SCHED; PG_LDA(At, 1, 0); PG_STAGE(PG_SA(0, 1), a2, aS1);
            PG_WAIT_V(8); PG_WAIT_L(0); PG_BAR; PG_MMA(0, 0, At, B0); PG_MMA(0, 1, At, B1); PG_BAR; PG_SCHED;
            PG_LDA(At, 1, 1); PG_STAGE(PG_SB(1, 0), b3, voffB); PG_STAGE(PG_SB(1, 1), b3 + hstepB, voffB); PG_STAGE(PG_SA(1, 0), a3, aS0);
            PG_WAIT_V(8); PG_WAIT_L(0); PG_BAR; PG_MMA(1, 0, At, B0); PG_MMA(1, 1, At, B1); PG_BAR; PG_SCHED;
        }
        if (wr == 0) PG_BAR;
        E(acc, cur, wr, wc, fr, fq);
        if (!has_next) break;
#pragma unroll
        for (int a = 0; a < 2; ++a)
#pragma unroll
            for (int b = 0; b < 2; ++b)
#pragma unroll
                for (int m = 0; m < 4; ++m)
#pragma unroll
                    for (int n = 0; n < 2; ++n) acc[a][b][m][n] = (f32x4){0.f, 0.f, 0.f, 0.f};
        cur = nxt; cB = nB; ++ui;
#pragma unroll
        for (int i = 0; i < 2; ++i) { aC0[i] = aN0[i]; aC1[i] = aN1[i]; }
        if (wr == 1) PG_BAR;
    }
    PG_WAIT_V(0);
    PG_BAR;
#undef PG_SA
#undef PG_SB
#undef PG_STAGE
#undef PG_LDA
#undef PG_LDB
#undef PG_MMA
#undef PG_WAIT_V
#undef PG_WAIT_L
#undef PG_BAR
#undef PG_SCHED
}
}

typedef f32x4 AccT[2][2][4][2];
__device__ __forceinline__ void st4(bf16_t* p, f32x4 v) { u32x2 w; w.x = pk2(v[0], v[1]); w.y = pk2(v[2], v[3]); *(u32x2*)p = w; }

struct DenseProb {
    struct Unit { int pm, pn; };
    const char* Abase; unsigned lda_bytes; const char* Bt; unsigned ldb_bytes; int K, nM, nN, G, c;
    __device__ __forceinline__ bool next(int i, Unit& u) const { return pg::static_order(i, G, c, nM, nN, u.pm, u.pn); }
    __device__ __forceinline__ int arow(const Unit& u, int r) const { return u.pm * 256 + r; }
    __device__ __forceinline__ const char* bbase(const Unit& u) const { return Bt + (size_t)u.pn * 256 * ldb_bytes; }
};
struct MoeProb {
    struct Unit { int pm, pn, e; };
    const char* Abase; unsigned lda_bytes; const char* Bt; size_t bexp_bytes; unsigned ldb_bytes; int K, nM, nN, G, c;
    const int* slot_tok; const LAS int* tstart;
    __device__ __forceinline__ bool next(int i, Unit& u) const {
        if (!pg::static_order(i, G, c, nM, nN, u.pm, u.pn)) return false;
        int e = 0;
#pragma unroll 1
        for (int k = 1; k < NEXP; ++k) e += (tstart[k] <= u.pm) ? 1 : 0;
        u.e = __builtin_amdgcn_readfirstlane(e); return true;
    }
    __device__ __forceinline__ int arow(const Unit& u, int r) const { return slot_tok ? slot_tok[u.pm * 256 + r] : u.pm * 256 + r; }
    __device__ __forceinline__ const char* bbase(const Unit& u) const { return Bt + (size_t)u.e * bexp_bytes + (size_t)u.pn * 256 * ldb_bytes; }
};

struct EpiPlain {
    bf16_t* O; int ldc;
    template <class U> __device__ __forceinline__ void operator()(const AccT& acc, const U& u, int wr, int wc, int fr, int fq) const {
        const int row0 = u.pm * 256 + wr * 64 + fr, col0 = u.pn * 256 + wc * 32 + 4 * fq;
#pragma unroll
        for (int ai = 0; ai < 2; ++ai)
#pragma unroll
            for (int m = 0; m < 4; ++m) { bf16_t* rowp = O + (size_t)(row0 + ai * 128 + m * 16) * ldc + col0;
#pragma unroll
                for (int bj = 0; bj < 2; ++bj)
#pragma unroll
                    for (int n = 0; n < 2; ++n) st4(rowp + bj * 128 + n * 16, acc[ai][bj][m][n]); }
    }
};
struct EpiProjA {
    bf16_t* O; const f32x2* rope;
    template <class U> __device__ __forceinline__ void operator()(const AccT& acc, const U& u, int wr, int wc, int fr, int fq) const {
        const int row0 = u.pm * 256 + wr * 64 + fr, col0 = u.pn * 256 + wc * 32 + 4 * fq;
        const int region = u.pn / 3;
        const float scale = (region == 0 || region == 3) ? C2_64 : 1.f;
        const bool do_rope = (region <= 1) && ((wc & 1) == 0);
#pragma unroll
        for (int ai = 0; ai < 2; ++ai)
#pragma unroll
            for (int m = 0; m < 4; ++m) { const int row = row0 + ai * 128 + m * 16; bf16_t* rowp = O + (size_t)row * A_IN + col0;
                f32x4 cs0 = {1.f, 0.f, 1.f, 0.f}, cs1 = {1.f, 0.f, 1.f, 0.f};
                if (do_rope) { const f32x4* rp = (const f32x4*)(rope + (size_t)(row & (SEQ - 1)) * 8 + 4 * (fq & 1)); cs0 = rp[0]; cs1 = rp[1]; }
#pragma unroll
                for (int bj = 0; bj < 2; ++bj)
#pragma unroll
                    for (int n = 0; n < 2; ++n) { f32x4 v = acc[ai][bj][m][n];
                        if (n == 0 && do_rope) {
                            f32x4 o; o[0] = __shfl_xor(v[0], 32); o[1] = __shfl_xor(v[1], 32); o[2] = __shfl_xor(v[2], 32); o[3] = __shfl_xor(v[3], 32);
                            const float sg = (fq < 2) ? -1.f : 1.f;
                            v[0] = v[0] * cs0[0] + sg * o[0] * cs0[1]; v[1] = v[1] * cs0[2] + sg * o[1] * cs0[3];
                            v[2] = v[2] * cs1[0] + sg * o[2] * cs1[1]; v[3] = v[3] * cs1[2] + sg * o[3] * cs1[3]; }
                        st4(rowp + bj * 128 + n * 16, v * scale); } }
    }
};
struct EpiGateUp {
    bf16_t* H;
    template <class U> __device__ __forceinline__ void operator()(const AccT& acc, const U& u, int wr, int wc, int fr, int fq) const {
        const int row0 = u.pm * 256 + wr * 64 + fr, col0 = u.pn * 128 + wc * 32 + 4 * fq;
#pragma unroll
        for (int ai = 0; ai < 2; ++ai)
#pragma unroll
            for (int m = 0; m < 4; ++m) { bf16_t* rowp = H + (size_t)(row0 + ai * 128 + m * 16) * DEXP + col0;
#pragma unroll
                for (int n = 0; n < 2; ++n) { const f32x4 g = acc[ai][0][m][n], up = acc[ai][1][m][n]; f32x4 h;
#pragma unroll
                    for (int j = 0; j < 4; ++j) h[j] = g[j] / (1.f + __expf(-g[j])) * up[j];
                    st4(rowp + n * 16, h); } }
    }
};
struct EpiProjB {
    bf16_t* O; const f32x2* rope; float* RQ; float* RKV;
    template <class U> __device__ __forceinline__ void operator()(const AccT& acc, const U& u, int wr, int wc, int fr, int fq) const {
        const int row0 = u.pm * 256 + wr * 64 + fr, col0 = u.pn * 256 + wc * 32 + 4 * fq;
#pragma unroll
        for (int ai = 0; ai < 2; ++ai)
#pragma unroll
            for (int m = 0; m < 4; ++m) { const int row = row0 + ai * 128 + m * 16; bf16_t* rowp = O + (size_t)row * B_INP + col0;
                if (u.pn == 0) {
                    float ss = 0.f;
#pragma unroll
                    for (int bj = 0; bj < 2; ++bj)
#pragma unroll
                        for (int n = 0; n < 2; ++n) { const f32x4 v = acc[ai][bj][m][n]; ss += (v[0] * v[0] + v[1] * v[1]) + (v[2] * v[2] + v[3] * v[3]); st4(rowp + bj * 128 + n * 16, v); }
                    ss += __shfl_xor(ss, 16); ss += __shfl_xor(ss, 32);
                    if (fq == 0) RQ[(size_t)row * 4 + wc] = ss;
                } else if (u.pn == 1) {
                    float ss = 0.f;
#pragma unroll
                    for (int n = 0; n < 2; ++n) { const f32x4 v = acc[ai][0][m][n]; ss += (v[0] * v[0] + v[1] * v[1]) + (v[2] * v[2] + v[3] * v[3]); st4(rowp + n * 16, v); }
                    ss += __shfl_xor(ss, 16); ss += __shfl_xor(ss, 32);
                    if (fq == 0) RKV[(size_t)row * 4 + wc] = ss;
                    if (wc == 0) {
                        const f32x4* rp = (const f32x4*)(rope + (size_t)(row & (SEQ - 1)) * 16 + 4 * fq); const f32x4 cs0 = rp[0], cs1 = rp[1];
                        const f32x4 a = acc[ai][1][m][0], b = acc[ai][1][m][1]; f32x4 oa, ob;
                        oa[0] = a[0] * cs0[0] - b[0] * cs0[1]; ob[0] = b[0] * cs0[0] + a[0] * cs0[1];
                        oa[1] = a[1] * cs0[2] - b[1] * cs0[3]; ob[1] = b[1] * cs0[2] + a[1] * cs0[3];
                        oa[2] = a[2] * cs1[0] - b[2] * cs1[1]; ob[2] = b[2] * cs1[0] + a[2] * cs1[1];
                        oa[3] = a[3] * cs1[2] - b[3] * cs1[3]; ob[3] = b[3] * cs1[2] + a[3] * cs1[3];
                        st4(rowp + 128, oa); st4(rowp + 128 + 16, ob);
                    } else {
#pragma unroll
                        for (int n = 0; n < 2; ++n) st4(rowp + 128 + n * 16, acc[ai][1][m][n] * C2_64);
                    }
                } else {
#pragma unroll
                    for (int bj = 0; bj < 2; ++bj)
#pragma unroll
                        for (int n = 0; n < 2; ++n) st4(rowp + bj * 128 + n * 16, acc[ai][bj][m][n] * C2_64);
                }
            }
    }
};
struct EpiQ {
    bf16_t* O; const f32x2* rope; const float* RQ;
    template <class U> __device__ __forceinline__ void operator()(const AccT& acc, const U& u, int wr, int wc, int fr, int fq) const {
        const int row0 = u.pm * 256 + wr * 64 + fr, col0 = u.pn * 256 + wc * 32 + 4 * fq;
#pragma unroll
        for (int ai = 0; ai < 2; ++ai)
#pragma unroll
            for (int m = 0; m < 4; ++m) { const int row = row0 + ai * 128 + m * 16; bf16_t* rowp = O + (size_t)row * 768 + col0;
                const f32x4 q4 = *(const f32x4*)(RQ + (size_t)row * 4);
                const float rs = (1.0f / sqrtf(((q4[0] + q4[1]) + (q4[2] + q4[3])) * (1.f / 256.f) + RMS_EPS)) * C2_96;
                const f32x4* rp = (const f32x4*)(rope + (size_t)(row & (SEQ - 1)) * 16 + 4 * fq); const f32x4 cs0 = rp[0], cs1 = rp[1];
#pragma unroll
                for (int bj = 0; bj < 2; ++bj) { const int grp = u.pn * 8 + bj * 4 + wc;
                    if (grp % 3 == 2) {
                        const f32x4 a = acc[ai][bj][m][0] * rs, b = acc[ai][bj][m][1] * rs; f32x4 oa, ob;
                        oa[0] = a[0] * cs0[0] - b[0] * cs0[1]; ob[0] = b[0] * cs0[0] + a[0] * cs0[1];
                        oa[1] = a[1] * cs0[2] - b[1] * cs0[3]; ob[1] = b[1] * cs0[2] + a[1] * cs0[3];
                        oa[2] = a[2] * cs1[0] - b[2] * cs1[1]; ob[2] = b[2] * cs1[0] + a[2] * cs1[1];
                        oa[3] = a[3] * cs1[2] - b[3] * cs1[3]; ob[3] = b[3] * cs1[2] + a[3] * cs1[3];
                        st4(rowp + bj * 128, oa); st4(rowp + bj * 128 + 16, ob);
                    } else {
#pragma unroll
                        for (int n = 0; n < 2; ++n) st4(rowp + bj * 128 + n * 16, acc[ai][bj][m][n] * rs);
                    } } }
    }
};
struct EpiKV {
    bf16_t* O; const float* RKV;
    template <class U> __device__ __forceinline__ void operator()(const AccT& acc, const U& u, int wr, int wc, int fr, int fq) const {
        const int row0 = u.pm * 256 + wr * 64 + fr, col0 = u.pn * 256 + wc * 32 + 4 * fq;
#pragma unroll
        for (int ai = 0; ai < 2; ++ai)
#pragma unroll
            for (int m = 0; m < 4; ++m) { const int row = row0 + ai * 128 + m * 16; bf16_t* rowp = O + (size_t)row * 1024 + col0;
                const f32x4 q4 = *(const f32x4*)(RKV + (size_t)row * 4);
                const float rs = 1.0f / sqrtf(((q4[0] + q4[1]) + (q4[2] + q4[3])) * (1.f / 128.f) + RMS_EPS);
#pragma unroll
                for (int bj = 0; bj < 2; ++bj)
#pragma unroll
                    for (int n = 0; n < 2; ++n) st4(rowp + bj * 128 + n * 16, acc[ai][bj][m][n] * rs); }
    }
};

struct AttnJob {
    const bf16_t* Q; const bf16_t* K0; const bf16_t* K1; const bf16_t* V; bf16_t* O; float* LSE;
    int qs, k0s, k1s, vs, os, lses;
    int q0;
    int kt_lo, kt_hi;
};
constexpr int ATT_KVB = 20480, ATT_WSF = 2 * ATT_KVB, ATT_OST = ATT_WSF + 2048, ATT_LDS = ATT_OST + 8 * 4096;
static_assert(ATT_LDS <= RING_BYTES, "attention LDS");
__device__ __forceinline__ int crow(int r, int hi) { return (r & 3) + 8 * (r >> 2) + 4 * hi; }
__device__ __forceinline__ float max3f(float a, float b, float c) { return __builtin_fmaxf(__builtin_fmaxf(a, b), c); }
typedef short v4i16_t __attribute__((ext_vector_type(4)));
__device__ __forceinline__ s16x4 vtr(const LAS unsigned char* p) { return __builtin_bit_cast(s16x4, __builtin_amdgcn_ds_read_tr16_b64_v4i16((LAS v4i16_t*)p)); }

template <int DQC, bool BANDED, bool WLSE>
__device__ __forceinline__ void attn_unit(const AttnJob& J, LAS unsigned char* lds) {
    const int tid = threadIdx.x, lane = tid & 63, r32 = lane & 31, hi = lane >> 5; const int wid = __builtin_amdgcn_readfirstlane(tid >> 6);
    constexpr int KOFFV = DQC * 2 * 1024;
    constexpr float NEG = -1e30f, THR = 6.0f;
    LAS float* wsf = (LAS float*)(lds + ATT_WSF) + wid * 64;
    const bf16_t* ksrcA = J.K0 + (size_t)lane * J.k0s + wid * 8;
    const bf16_t* ksrcB = (DQC > 4) ? (J.K1 + (size_t)lane * J.k1s + wid * 8) : ksrcA;
    const bf16_t* vsrc = J.V + (size_t)(16 * (wid & 3) + (lane >> 2)) * J.vs + (wid >> 2) * 32 + (lane & 3) * 8;
#define ATT_STAGE(t, b) do { \
        __builtin_amdgcn_global_load_lds((const unsigned*)(ksrcA + (size_t)(t) * 64 * J.k0s), (LAS unsigned*)(lds + (b) * ATT_KVB + wid * 1024), 16, 0, 0); \
        if (DQC > 4 && wid < 2 * DQC - 8) __builtin_amdgcn_global_load_lds((const unsigned*)(ksrcB + (size_t)(t) * 64 * J.k1s), (LAS unsigned*)(lds + (b) * ATT_KVB + (8 + wid) * 1024), 16, 0, 0); \
        __builtin_amdgcn_global_load_lds((const unsigned*)(vsrc + (size_t)(t) * 64 * J.vs), (LAS unsigned*)(lds + (b) * ATT_KVB + KOFFV + wid * 1024), 16, 0, 0); } while (0)
    ATT_STAGE(J.kt_lo, 0);
    bf16x8 qr[DQC];
    { const bf16_t* qp = J.Q + (size_t)(wid * 32 + r32) * J.qs + hi * 8;
#pragma unroll
      for (int d0 = 0; d0 < DQC; ++d0) qr[d0] = *(const bf16x8*)(qp + d0 * 16); }
    float m_run = NEG, l_run = 0.f; f32x16 o[2];
#pragma unroll
    for (int r = 0; r < 16; ++r) { o[0][r] = 0.f; o[1][r] = 0.f; }
    const int qi = J.q0 + wid * 32 + r32;
    const int ta = (J.q0 + wid * 32) >> 6;
    const int vlane = ((lane >> 4) & 1) * 32 + (lane & 3) * 8 + (4 * hi + ((lane & 15) >> 2)) * 64;
    VM_WAIT(); __syncthreads();
    for (int t = J.kt_lo; t < J.kt_hi; ++t) {
        const int b = (t - J.kt_lo) & 1;
        if (t + 1 < J.kt_hi) ATT_STAGE(t + 1, b ^ 1);
        if (!BANDED || (t >= ta - 1 && t <= ta + 1)) {
            const LAS unsigned char* kb = lds + b * ATT_KVB + hi * 1024 + r32 * 16;
            f32x16 p0, p1;
#pragma unroll
            for (int r = 0; r < 16; ++r) { p0[r] = 0.f; p1[r] = 0.f; }
#pragma unroll
            for (int d0 = 0; d0 < DQC; ++d0) {
                const bf16x8 k0f = *(const LAS bf16x8*)(kb + d0 * 2048), k1f = *(const LAS bf16x8*)(kb + d0 * 2048 + 512);
                p0 = __builtin_amdgcn_mfma_f32_32x32x16_bf16(k0f, qr[d0], p0, 0, 0, 0);
                p1 = __builtin_amdgcn_mfma_f32_32x32x16_bf16(k1f, qr[d0], p1, 0, 0, 0); }
            if (BANDED) { const int kb0 = t * 64 + 4 * hi - qi;
#pragma unroll
                for (int r = 0; r < 16; ++r) { const int dk = kb0 + (r & 3) + 8 * (r >> 2);
                    if (dk > 64 || dk < -64) p0[r] = NEG;
                    if (dk + 32 > 64 || dk + 32 < -64) p1[r] = NEG; } }
            float rm;
            { float a = max3f(p0[0], p0[1], p1[0]), c = max3f(p0[2], p0[3], p1[1]); a = max3f(a, p1[2], p1[3]);
#pragma unroll
              for (int r = 4; r < 16; r += 4) { a = max3f(a, p0[r], p0[r + 1]); c = max3f(c, p0[r + 2], p0[r + 3]); a = max3f(a, p1[r], p1[r + 1]); c = max3f(c, p1[r + 2], p1[r + 3]); }
              rm = __builtin_fmaxf(a, c);
              auto rr = __builtin_amdgcn_permlane32_swap(__float_as_uint(rm), __float_as_uint(rm), false, false);
              rm = __builtin_fmaxf(__uint_as_float(rr[0]), __uint_as_float(rr[1])); }
            if (__any(rm > m_run + THR)) {
                const float mn = __builtin_fmaxf(m_run, rm); const float f = __builtin_amdgcn_exp2f(m_run - mn);
                l_run *= f; m_run = mn;
                if (hi == 0) wsf[r32] = f;
                LDS_WAIT();
#pragma unroll
                for (int g = 0; g < 4; ++g) { const f32x4 fv = *(const LAS f32x4*)(wsf + 8 * g + 4 * hi);
#pragma unroll
                    for (int j = 0; j < 4; ++j) { o[0][4 * g + j] *= fv[j]; o[1][4 * g + j] *= fv[j]; } }
            }
            float sacc = 0.f;
#pragma unroll
            for (int r = 0; r < 16; ++r) { p0[r] = __builtin_amdgcn_exp2f(p0[r] - m_run); p1[r] = __builtin_amdgcn_exp2f(p1[r] - m_run); sacc += p0[r] + p1[r]; }
            l_run += sacc;
            bf16x8 pa[4];
#pragma unroll
            for (int ks = 0; ks < 4; ++ks) { u32x4 w;
#pragma unroll
                for (int jj = 0; jj < 4; ++jj) { const int r = 8 * (ks & 1) + 2 * jj; w[jj] = (ks < 2) ? pk2(p0[r], p0[r + 1]) : pk2(p1[r], p1[r + 1]); }
                pa[ks] = __builtin_bit_cast(bf16x8, w); }
            const LAS unsigned char* vb = lds + b * ATT_KVB + KOFFV + vlane;
#pragma unroll
            for (int dh = 0; dh < 2; ++dh)
#pragma unroll
                for (int ks = 0; ks < 4; ++ks) {
                    const s16x4 lo = vtr(vb + dh * 4096 + ks * 1024), hi4 = vtr(vb + dh * 4096 + ks * 1024 + 512);
                    const bf16x8 vf = (bf16x8){lo[0], lo[1], lo[2], lo[3], hi4[0], hi4[1], hi4[2], hi4[3]};
                    o[dh] = __builtin_amdgcn_mfma_f32_32x32x16_bf16(pa[ks], vf, o[dh], 0, 0, 0); }
        }
        VM_WAIT(); __syncthreads();
    }
    { auto rr = __builtin_amdgcn_permlane32_swap(__float_as_uint(l_run), __float_as_uint(l_run), false, false); l_run = __uint_as_float(rr[0]) + __uint_as_float(rr[1]); }
    if (hi == 0) wsf[32 + r32] = l_run;
    if (WLSE) { if (hi == 0) J.LSE[(size_t)(wid * 32 + r32) * J.lses] = m_run + __log2f(l_run); }
    LDS_WAIT();
    LAS bf16_t* stg = (LAS bf16_t*)(lds + ATT_OST) + wid * 2048;
#pragma unroll
    for (int g = 0; g < 4; ++g) { const f32x4 lv = *(const LAS f32x4*)(wsf + 32 + 8 * g + 4 * hi);
#pragma unroll
        for (int j = 0; j < 4; ++j) { const int r = 4 * g + j; const float rl = 1.0f / lv[j]; const int orow = crow(r, hi);
            stg[orow * 64 + r32] = (bf16_t)(pk2(o[0][r] * rl, 0.f) & 0xffffu); stg[orow * 64 + 32 + r32] = (bf16_t)(pk2(o[1][r] * rl, 0.f) & 0xffffu); } }
    LDS_WAIT();
    bf16_t* Ow = J.O + (size_t)(wid * 32) * J.os;
#pragma unroll
    for (int i = 0; i < 4; ++i) { const int row = i * 8 + (lane >> 3), ch = lane & 7; const u32x4 v = *(const LAS u32x4*)(stg + row * 64 + ch * 8); *(u32x4*)(Ow + (size_t)row * J.os + ch * 8) = v; }
    LDS_WAIT(); __syncthreads();
#undef ATT_STAGE
}

constexpr int MISC_HIST = MISC_OFF + 256, MISC_TSTART = MISC_OFF + 512, MISC_TOT = MISC_OFF + 768, MISC_PRE = MISC_OFF + 896, MISC_PSTART = MISC_OFF + 1024, MISC_RANK = MISC_OFF + 1152;

__device__ __forceinline__ void tr_item(const float* W, int ldw, int k0, int n0, bf16_t* WT, int ldt, int orow0, int kout0, const float* kscale, LAS float* scr, int lane) {
#pragma unroll 8
    for (int i = 0; i < 32; ++i) { const int kk = 2 * i + (lane >> 5); float v = W[(size_t)(k0 + kk) * ldw + n0 + (lane & 31)]; if (kscale) v *= kscale[k0 + kk]; scr[kk * 33 + (lane & 31)] = v; }
    LDS_WAIT();
    const int c = lane & 7;
#pragma unroll
    for (int j = 0; j < 4; ++j) { const int n = (lane >> 3) + 8 * j; const LAS float* s = scr + (8 * c) * 33 + n;
        u32x4 o; o.x = pk2(s[0 * 33], s[1 * 33]); o.y = pk2(s[2 * 33], s[3 * 33]); o.z = pk2(s[4 * 33], s[5 * 33]); o.w = pk2(s[6 * 33], s[7 * 33]);
        *(u32x4*)(WT + (size_t)(orow0 + n) * ldt + kout0 + k0 + 8 * c) = o; }
    LDS_WAIT();
}
struct ProIn { const float *x, *mem, *a_w_in, *a_w_out, *b_w_in, *b_q_norm, *b_w_qb, *b_kv_norm, *b_w_kvb, *b_w_out, *mem_w_kv, *w_grp, *w_exp, *w_gate, *w_up, *w_down; };
__device__ __forceinline__ void prologue_phase(const ProIn& I, unsigned char* ws, LAS unsigned char* lds, int gw, int NGW, int lane) {
    LAS float* scr = (LAS float*)(lds + (threadIdx.x >> 6) * 16384);
    constexpr int I0 = 16 * 80, I1 = 8 * 32, I2 = 16 * 21, I3 = 4 * 24, I4 = 2 * 32, I5 = 12 * 32, I6 = 16 * 16, I7 = 16 * 16;
    constexpr int NSMALL = I0 + I1 + I2 + I3 + I4 + I5 + I6 + I7, NEXPI = 64 * 768;
    for (int it = gw; it < NSMALL + NEXPI; it += NGW) {
        int r = it;
        if (r < NSMALL) {
            const float* W; int K, N; size_t wt; int ldt, kout0 = 0, orow = 0; const float* ks = nullptr;
            if (r < I0) { W = I.a_w_in; K = 1024; N = 2560; wt = WS_WINA; ldt = 1024; }
            else if ((r -= I0) < I1) { W = I.a_w_out; K = 512; N = 1024; wt = WS_WOUTA; ldt = 512; }
            else if ((r -= I1) < I2) { W = I.b_w_in; K = 1024; N = 672; wt = WS_WINB; ldt = 1024; }
            else if ((r -= I2) < I3) { W = I.b_w_qb; K = 256; N = 768; wt = WS_WQB; ldt = 256; ks = I.b_q_norm; }
            else if ((r -= I3) < I4) { W = I.b_w_kvb; K = 128; N = 1024; wt = WS_WKVB; ldt = 256; kout0 = 128; ks = I.b_kv_norm; }
            else if ((r -= I4) < I5) { W = I.b_w_out; K = 768; N = 1024; wt = WS_WOUTB; ldt = 768; }
            else if ((r -= I5) < I6) { W = I.mem_w_kv; K = 1024; N = 512; wt = WS_WMEM; ldt = 1024; }
            else { r -= I6; W = I.mem_w_kv + (size_t)1024 * 512; K = 1024; N = 512; wt = WS_WMEM; ldt = 1024; orow = 512; }
            const int nblk = N / 32, kb = r / nblk, nb = r % nblk;
            tr_item(W, N, kb * 64, nb * 32, (bf16_t*)(ws + wt), ldt, orow + nb * 32, kout0, ks, scr, lane);
        } else {
            r -= NSMALL; const int le = r / 768, q = r % 768, which = q / 256, s = q % 256;
            if (which < 2) {
                const float* W = (which == 0 ? I.w_gate : I.w_up) + (size_t)le * 1024 * 512; const int kb = s / 16, nb = s % 16, n0 = nb * 32;
                tr_item(W, 512, kb * 64, n0, (bf16_t*)(ws + WS_WGU) + (size_t)le * 1024 * 1024, 1024, 256 * (n0 >> 7) + 128 * which + (n0 & 127), 0, nullptr, scr, lane);
            } else {
                const float* W = I.w_down + (size_t)le * 512 * 1024; const int kb = s / 32, nb = s % 32;
                tr_item(W, 1024, kb * 64, nb * 32, (bf16_t*)(ws + WS_WD) + (size_t)le * 1024 * 512, 512, nb * 32, 0, nullptr, scr, lane);
            }
        }
    }
    const size_t gt = (size_t)gw * 64 + lane, NGT = (size_t)NGW * 64;
    { u32x4 z = {0u, 0u, 0u, 0u};
      for (size_t i = gt; i < (size_t)96 * 1024 / 8; i += NGT) *(u32x4*)((bf16_t*)(ws + WS_WINB) + (size_t)672 * 1024 + i * 8) = z;
      for (size_t i = gt; i < (size_t)1024 * 16; i += NGT) *(u32x4*)((bf16_t*)(ws + WS_WKVB) + (i >> 4) * 256 + (i & 15) * 8) = z;
      for (size_t i = gt; i < (size_t)2 * 12 * 128; i += NGT) { const size_t l = i / (12 * 128), rem = i % (12 * 128); *(u32x4*)((bf16_t*)(ws + WS_WR) + (l * 48 + 36) * 1024 + rem * 8) = z; } }
    for (size_t i = gt; i < (size_t)2 * 36 * 1024; i += NGT) { const int l = (int)(i / (36 * 1024)), rem = (int)(i % (36 * 1024)), row = rem / 1024, k = rem % 1024;
        const float v = row < 4 ? I.w_grp[((size_t)l * 1024 + k) * 4 + row] : I.w_exp[((size_t)l * 1024 + k) * 32 + (row - 4)];
        ((bf16_t*)(ws + WS_WR))[((size_t)l * 48 + row) * 1024 + k] = (bf16_t)(pk2(v, 0.f) & 0xffffu); }
    for (size_t i = gt; i < (size_t)NTOK * DM / 8; i += NGT) { const f32x4 a = ((const f32x4*)I.x)[2 * i], b = ((const f32x4*)I.x)[2 * i + 1];
        u32x4 o; o.x = pk2(a[0], a[1]); o.y = pk2(a[2], a[3]); o.z = pk2(b[0], b[1]); o.w = pk2(b[2], b[3]); ((u32x4*)(ws + WS_X))[i] = o; }
    for (size_t i = gt; i < (size_t)NMEM * DM / 8; i += NGT) { const f32x4 a = ((const f32x4*)I.mem)[2 * i], b = ((const f32x4*)I.mem)[2 * i + 1];
        u32x4 o; o.x = pk2(a[0], a[1]); o.y = pk2(a[2], a[3]); o.z = pk2(b[0], b[1]); o.w = pk2(b[2], b[3]); ((u32x4*)(ws + WS_MEMB))[i] = o; }
    for (size_t i = gt; i < (size_t)SEQ * 8; i += NGT) { const int pos = (int)(i >> 3), k = (int)(i & 7); const float inv = powf(500000.0f, -((float)(2 * k) / 16.0f)); const float ang = (float)pos * inv;
        ((f32x2*)(ws + WS_ROPEA))[i] = (f32x2){cosf(ang), sinf(ang)}; }
    for (size_t i = gt; i < (size_t)SEQ * 16; i += NGT) { const int pos = (int)(i >> 4), k = (int)(i & 15); const float inv = powf(500000.0f, -((float)(2 * k) / 32.0f)); const float ang = (float)pos * inv;
        ((f32x2*)(ws + WS_ROPEB))[i] = (f32x2){cosf(ang), sinf(ang)}; }
}

__device__ __forceinline__ void merge_phase(unsigned char* ws, int gw, int NGW, int lane) {
    const bf16_t* OG = (const bf16_t*)(ws + WS_OG); const float* LSE = (const float*)(ws + WS_LSE); bf16_t* CAT = (bf16_t*)(ws + WS_CAT);
    for (int tok = gw; tok < NTOK; tok += NGW) {
        const int j = lane >> 4;
        float l0 = LSE[(size_t)tok * 4 + j], l1 = LSE[(size_t)NTOK * 4 + (size_t)tok * 4 + j], l2 = LSE[(size_t)2 * NTOK * 4 + (size_t)tok * 4 + j];
        const float mx = max3f(l0, l1, l2); l0 = __builtin_amdgcn_exp2f(l0 - mx); l1 = __builtin_amdgcn_exp2f(l1 - mx); l2 = __builtin_amdgcn_exp2f(l2 - mx);
        const float inv = 1.0f / (l0 + l1 + l2);
        const u32x2 a = *(const u32x2*)(OG + (size_t)tok * 256 + lane * 4), b = *(const u32x2*)(OG + (size_t)NTOK * 256 + (size_t)tok * 256 + lane * 4), c = *(const u32x2*)(OG + (size_t)2 * NTOK * 256 + (size_t)tok * 256 + lane * 4);
        f32x4 v;
        v[0] = (l0 * bflo(a.x) + l1 * bflo(b.x) + l2 * bflo(c.x)) * inv; v[1] = (l0 * bfhi(a.x) + l1 * bfhi(b.x) + l2 * bfhi(c.x)) * inv;
        v[2] = (l0 * bflo(a.y) + l1 * bflo(b.y) + l2 * bflo(c.y)) * inv; v[3] = (l0 * bfhi(a.y) + l1 * bfhi(b.y) + l2 * bfhi(c.y)) * inv;
        st4(CAT + (size_t)tok * 512 + lane * 4, v);
    }
}

__device__ __forceinline__ void ln_core(float (&v)[16], const float (&g)[16], const float (&b)[16]) {
    float s = 0.f;
#pragma unroll
    for (int i = 0; i < 16; ++i) s += v[i];
    const float mean = wave_sum(s) * (1.f / DM); float q = 0.f;
#pragma unroll
    for (int i = 0; i < 16; ++i) { v[i] -= mean; q += v[i] * v[i]; }
    const float rstd = 1.0f / sqrtf(wave_sum(q) * (1.f / DM) + LN_EPS);
#pragma unroll
    for (int i = 0; i < 16; ++i) v[i] = v[i] * rstd * g[i] + b[i];
}
__device__ __forceinline__ void load_gb(const float* gp, const float* bp, int lane, float (&g)[16], float (&b)[16]) {
#pragma unroll
    for (int h = 0; h < 2; ++h)
#pragma unroll
        for (int q = 0; q < 2; ++q) { const f32x4 gv = *(const f32x4*)(gp + h * 512 + lane * 8 + q * 4), bv = *(const f32x4*)(bp + h * 512 + lane * 8 + q * 4);
#pragma unroll
            for (int j = 0; j < 4; ++j) { g[h * 8 + q * 4 + j] = gv[j]; b[h * 8 + q * 4 + j] = bv[j]; } }
}
__device__ __forceinline__ void unpack8(const u32x4 w, float* o) { o[0] = bflo(w.x); o[1] = bfhi(w.x); o[2] = bflo(w.y); o[3] = bfhi(w.y); o[4] = bflo(w.z); o[5] = bfhi(w.z); o[6] = bflo(w.w); o[7] = bfhi(w.w); }
__device__ __forceinline__ u32x4 pack8(const float* v) { u32x4 o; o.x = pk2(v[0], v[1]); o.y = pk2(v[2], v[3]); o.z = pk2(v[4], v[5]); o.w = pk2(v[6], v[7]); return o; }

__device__ __forceinline__ void ln_mix_phase(unsigned char* ws, const float* lng, const float* lnb, int gw, int NGW, int lane) {
    const bf16_t* X = (const bf16_t*)(ws + WS_X); bf16_t* XO = (bf16_t*)(ws + WS_XB); const bf16_t* Y = (const bf16_t*)(ws + WS_Y);
    float g[16], b[16]; load_gb(lng, lnb, lane, g, b);
    for (int row = gw; row < NTOK; row += NGW) {
        const size_t ro = (size_t)row * DM;
        const u32x4 xa = *(const u32x4*)(X + ro + lane * 8), xb = *(const u32x4*)(X + ro + 512 + lane * 8);
        const u32x4 ya = *(const u32x4*)(Y + ro + lane * 8), yb = *(const u32x4*)(Y + ro + 512 + lane * 8);
        float v[16], t[16]; unpack8(xa, v); unpack8(xb, v + 8); unpack8(ya, t); unpack8(yb, t + 8);
#pragma unroll
        for (int i = 0; i < 16; ++i) v[i] = ALPHA * v[i] + t[i];
        ln_core(v, g, b);
        *(u32x4*)(XO + ro + lane * 8) = pack8(v); *(u32x4*)(XO + ro + 512 + lane * 8) = pack8(v + 8);
    }
}
constexpr int RT_WROW = 2064, RT_SC = 102400;
__device__ __forceinline__ void router_phase(unsigned char* ws, const bf16_t* WR, const float* bgrp, const float* bexp, LAS unsigned char* lds, int vcu, int G, int wave, int lane) {
    const bf16_t* X = (const bf16_t*)(ws + WS_XB);
    int* tok_eid = (int*)(ws + WS_TOKEID); float* tok_gw = (float*)(ws + WS_TOKGW); unsigned* wgcnt = (unsigned*)(ws + WS_WGCNT);
    for (int idx = threadIdx.x; idx < 48 * 128; idx += NTHREADS) { const int row = idx >> 7, ch = idx & 127; *(LAS u32x4*)(lds + row * RT_WROW + ch * 16) = *(const u32x4*)(WR + (size_t)row * 1024 + ch * 8); }
    LAS int* hist = (LAS int*)(lds + MISC_HIST);
    if (threadIdx.x < 32) hist[threadIdx.x] = 0;
    __syncthreads();
    LAS float* sc = (LAS float*)(lds + RT_SC) + wave * 768;
    for (int task = vcu * NWAVES + wave; task < NTOK / 16; task += G * NWAVES) {
        const int row0 = task * 16;
        f32x4 acc[3];
#pragma unroll
        for (int n = 0; n < 3; ++n) acc[n] = (f32x4){0.f, 0.f, 0.f, 0.f};
        const bf16_t* ap = X + (size_t)(row0 + (lane & 15)) * DM + 8 * (lane >> 4);
        const LAS unsigned char* wb = lds + (lane & 15) * RT_WROW + (lane >> 4) * 16;
#pragma unroll 8
        for (int kk = 0; kk < 32; ++kk) { const bf16x8 a = *(const bf16x8*)(ap + kk * 32);
#pragma unroll
            for (int n = 0; n < 3; ++n) { const bf16x8 w = *(const LAS bf16x8*)(wb + n * 16 * RT_WROW + kk * 64); acc[n] = __builtin_amdgcn_mfma_f32_16x16x32_bf16(a, w, acc[n], 0, 0, 0); } }
#pragma unroll
        for (int n = 0; n < 3; ++n)
#pragma unroll
            for (int r = 0; r < 4; ++r) sc[((lane >> 4) * 4 + r) * 48 + n * 16 + (lane & 15)] = acc[n][r];
        LDS_WAIT();
        if (lane < 16) {
            const LAS float* lg = sc + lane * 48; const int tok = row0 + lane;
            const float g0 = lg[0] + bgrp[0], g1 = lg[1] + bgrp[1], g2 = lg[2] + bgrp[2], g3 = lg[3] + bgrp[3];
            int gi = 0; float gm = g0; if (g1 > gm) { gm = g1; gi = 1; } if (g2 > gm) { gm = g2; gi = 2; } if (g3 > gm) { gm = g3; gi = 3; }
            const float ggate = 1.0f / (__expf(g0 - gm) + __expf(g1 - gm) + __expf(g2 - gm) + __expf(g3 - gm));
            float b1 = -3.0e38f, b2 = -3.0e38f; int i1 = 0, i2 = 0;
#pragma unroll
            for (int k = 0; k < 8; ++k) { const float vv = lg[4 + gi * 8 + k] + bexp[gi * 8 + k];
                if (vv > b1) { b2 = b1; i2 = i1; b1 = vv; i1 = k; } else if (vv > b2) { b2 = vv; i2 = k; } }
            const float e2 = __expf(b2 - b1), p1 = 1.0f / (1.0f + e2), p2 = e2 * p1;
            const int e_1 = gi * 8 + i1, e_2 = gi * 8 + i2;
            *(int2*)(tok_eid + (size_t)tok * 2) = make_int2(e_1, e_2); *(float2*)(tok_gw + (size_t)tok * 2) = make_float2(p1 * ggate, p2 * ggate);
            atomicAdd((int*)(hist + e_1), 1); atomicAdd((int*)(hist + e_2), 1);
        }
        LDS_WAIT();
    }
    __syncthreads();
    if (threadIdx.x < 32) wgcnt[blockIdx.x * 32 + threadIdx.x] = (unsigned)hist[threadIdx.x];
}

__device__ __forceinline__ void assign_phase(unsigned char* ws, LAS unsigned char* lds, int vcu, int G, int wave, int lane) {
    const unsigned* wgcnt = (const unsigned*)(ws + WS_WGCNT); const int* tok_eid = (const int*)(ws + WS_TOKEID);
    int* tok_slot = (int*)(ws + WS_TOKSLOT); int* slot_tok = (int*)(ws + WS_SLOTTOK); int* meta = (int*)(ws + WS_META);
    LAS int* part = (LAS int*)lds;
    LAS int* tstart = (LAS int*)(lds + MISC_TSTART); LAS int* tot = (LAS int*)(lds + MISC_TOT); LAS int* pre = (LAS int*)(lds + MISC_PRE);
    LAS int* pstart = (LAS int*)(lds + MISC_PSTART); LAS int* rank = (LAS int*)(lds + MISC_RANK);
    const int tid = threadIdx.x, me = blockIdx.x;
    { const int e = tid & 31, p = tid >> 5; int t = 0, pr = 0;
      for (int w = p; w < G; w += 16) { const int v = (int)wgcnt[w * 32 + e]; t += v; if (w < me) pr += v; }
      part[(p * 32 + e) * 2] = t; part[(p * 32 + e) * 2 + 1] = pr; }
    __syncthreads();
    if (tid < 32) { int t = 0, pr = 0; for (int p = 0; p < 16; ++p) { t += part[(p * 32 + tid) * 2]; pr += part[(p * 32 + tid) * 2 + 1]; } tot[tid] = t; pre[tid] = pr; rank[tid] = 0; }
    __syncthreads();
    if (tid == 0) { int acc = 0; for (int e = 0; e < NEXP; ++e) { tstart[e] = acc; pstart[e] = acc * 256; acc += (tot[e] + 255) >> 8; } tstart[NEXP] = acc; }
    __syncthreads();
    if (me == 0 && tid <= NEXP) meta[tid] = tstart[tid];
    if (me == 0 && tid < NEXP) meta[64 + tid] = tot[tid];
    if (me < NEXP) { const int e = me, s0 = pstart[e] + tot[e], s1 = tstart[e + 1] * 256; for (int s = s0 + tid; s < s1; s += NTHREADS) slot_tok[s] = 0; }
    for (int task = vcu * NWAVES + wave; task < NTOK / 16; task += G * NWAVES) {
        if (lane < 32) { const int tok = task * 16 + (lane >> 1), k = lane & 1; const int e = tok_eid[(size_t)tok * 2 + k];
            const int rk = atomicAdd((int*)(rank + e), 1); const int slot = pstart[e] + pre[e] + rk;
            slot_tok[slot] = tok; tok_slot[(size_t)tok * 2 + k] = slot; }
    }
    __syncthreads();
}

template <bool FINAL>
__device__ __forceinline__ void ln_moe_phase(unsigned char* ws, const float* lng, const float* lnb, float* out, int gw, int NGW, int lane) {
    const bf16_t* XI = (const bf16_t*)(ws + WS_XB); bf16_t* X = (bf16_t*)(ws + WS_X); const bf16_t* YS = (const bf16_t*)(ws + WS_YS);
    const int* tok_slot = (const int*)(ws + WS_TOKSLOT); const float* tok_gw = (const float*)(ws + WS_TOKGW);
    float g[16], b[16]; load_gb(lng, lnb, lane, g, b);
    for (int tok = gw; tok < NTOK; tok += NGW) {
        const int2 sl = *(const int2*)(tok_slot + (size_t)tok * 2); const float2 gwt = *(const float2*)(tok_gw + (size_t)tok * 2);
        const size_t ro = (size_t)tok * DM;
        const u32x4 xa = *(const u32x4*)(XI + ro + lane * 8), xb = *(const u32x4*)(XI + ro + 512 + lane * 8);
        const u32x4 pa = *(const u32x4*)(YS + (size_t)sl.x * DM + lane * 8), pb = *(const u32x4*)(YS + (size_t)sl.x * DM + 512 + lane * 8);
        const u32x4 qa = *(const u32x4*)(YS + (size_t)sl.y * DM + lane * 8), qb = *(const u32x4*)(YS + (size_t)sl.y * DM + 512 + lane * 8);
        float v[16], t[16], u[16]; unpack8(xa, v); unpack8(xb, v + 8); unpack8(pa, t); unpack8(pb, t + 8); unpack8(qa, u); unpack8(qb, u + 8);
#pragma unroll
        for (int i = 0; i < 16; ++i) v[i] = ALPHA * v[i] + (gwt.x * t[i] + gwt.y * u[i]);
        ln_core(v, g, b);
        if (FINAL) {
#pragma unroll
            for (int h = 0; h < 2; ++h)
#pragma unroll
                for (int q = 0; q < 2; ++q) *(f32x4*)(out + ro + h * 512 + lane * 8 + q * 4) = (f32x4){v[h * 8 + q * 4], v[h * 8 + q * 4 + 1], v[h * 8 + q * 4 + 2], v[h * 8 + q * 4 + 3]};
        } else { *(u32x4*)(X + ro + lane * 8) = pack8(v); *(u32x4*)(X + ro + 512 + lane * 8) = pack8(v + 8); }
    }
}

__device__ __forceinline__ void mem_attn_units(const bf16_t* Qb, int qs, int qcol, const bf16_t* MK, int kcol, bf16_t* Ob, int os, int ocol, LAS unsigned char* lds, int vcu, int G) {
    const int upw = (1024 + G - 1) / G;
    for (int i = 0; i < upw; ++i) { const int u = vcu * upw + i; if (u >= 1024) break;
        const int b = u >> 6, h = (u >> 4) & 3, qb = u & 15;
        AttnJob J; J.Q = Qb + (size_t)(b * SEQ + qb * 256) * qs + qcol + h * 64; J.qs = qs;
        J.K0 = MK + (size_t)(b * MEML) * 1024 + kcol + h * 64; J.k0s = 1024; J.K1 = J.K0; J.k1s = 1024; J.V = J.K0 + 256; J.vs = 1024;
        J.O = Ob + (size_t)(b * SEQ + qb * 256) * os + ocol + h * 64; J.os = os; J.LSE = nullptr; J.lses = 0; J.q0 = 0; J.kt_lo = 0; J.kt_hi = MEML / 64;
        attn_unit<4, false, false>(J, lds); }
}
__device__ __forceinline__ void attn0_phase(unsigned char* ws, LAS unsigned char* lds, int vcu, int G) {
    const bf16_t* PROJ = (const bf16_t*)(ws + WS_PROJ); bf16_t* OG = (bf16_t*)(ws + WS_OG); float* LSE = (float*)(ws + WS_LSE);
    const int upw = (3072 + G - 1) / G;
    for (int i = 0; i < upw; ++i) { const int u = vcu * upw + i; if (u >= 3072) break;
        const int g = u >> 10, rem = u & 1023, j = rem & 3, rest = rem >> 2;
        const int dil = 1 << (2 * g), T = SEQ / dil, nqb = T / 256, n = rest / nqb, qb = rest % nqb, b = n / dil, r = n % dil;
        const size_t tok0 = (size_t)b * SEQ + r, tokq = tok0 + (size_t)dil * qb * 256; const int hc = (g * 4 + j) * 64;
        AttnJob J; J.Q = PROJ + tokq * A_IN + hc; J.qs = dil * A_IN;
        J.K0 = PROJ + tok0 * A_IN + 768 + hc; J.k0s = dil * A_IN; J.K1 = J.K0; J.k1s = J.k0s; J.V = PROJ + tok0 * A_IN + 1536 + hc; J.vs = dil * A_IN;
        J.O = OG + (size_t)g * NTOK * 256 + tokq * 256 + j * 64; J.os = dil * 256;
        J.LSE = LSE + (size_t)g * NTOK * 4 + tokq * 4 + j; J.lses = dil * 4;
        J.q0 = qb * 256; J.kt_lo = (qb * 4 - 1 > 0) ? qb * 4 - 1 : 0; J.kt_hi = (qb * 4 + 5 < T / 64) ? qb * 4 + 5 : T / 64;
        attn_unit<4, true, true>(J, lds); }
    mem_attn_units(PROJ, A_IN, 2304, (const bf16_t*)(ws + WS_MEMKV), 0, (bf16_t*)(ws + WS_CAT), 512, 256, lds, vcu, G);
}
__device__ __forceinline__ void attn1_phase(unsigned char* ws, LAS unsigned char* lds, int vcu, int G) {
    const bf16_t* QBp = (const bf16_t*)(ws + WS_QB); const bf16_t* KVp = (const bf16_t*)(ws + WS_KV); const bf16_t* PB = (const bf16_t*)(ws + WS_PROJB); bf16_t* ATT = (bf16_t*)(ws + WS_ATT);
    const int upw = (2048 + G - 1) / G;
    for (int i = 0; i < upw; ++i) {
        int bh, qb;
        if (G == 256) { const int x = vcu >> 5, w = vcu & 31; bh = x * 16 + 2 * i + (w >> 4); qb = w & 15; }
        else { const int u = vcu * upw + i; if (u >= 2048) break; bh = u >> 4; qb = u & 15; }
        const int b = bh >> 3, h = bh & 7;
        AttnJob J; J.Q = QBp + (size_t)(b * SEQ + qb * 256) * 768 + h * 96; J.qs = 768;
        J.K0 = KVp + (size_t)b * SEQ * 1024 + h * 128; J.k0s = 1024; J.K1 = PB + (size_t)b * SEQ * B_INP + 384; J.k1s = B_INP; J.V = KVp + (size_t)b * SEQ * 1024 + h * 128 + 64; J.vs = 1024;
        J.O = ATT + (size_t)(b * SEQ + qb * 256) * 768 + h * 64; J.os = 768; J.LSE = nullptr; J.lses = 0; J.q0 = qb * 256; J.kt_lo = 0; J.kt_hi = SEQ / 64;
        attn_unit<6, false, false>(J, lds); }
    mem_attn_units(PB, B_INP, 416, (const bf16_t*)(ws + WS_MEMKV), 512, ATT, 768, 512, lds, vcu, G);
}

constexpr int NPH = 21;
struct Args { const float* in[22]; float* out; unsigned char* ws; int ph_lo, ph_hi; };
__device__ __forceinline__ DenseProb dense(const void* A, unsigned lda_el, const void* Bt, unsigned ldb_el, int M, int N, int K, int G) {
    DenseProb p; p.Abase = (const char*)A; p.lda_bytes = lda_el * 2u; p.Bt = (const char*)Bt; p.ldb_bytes = ldb_el * 2u; p.K = K; p.nM = M / 256; p.nN = N / 256; p.G = G; p.c = (int)blockIdx.x; return p; }

__global__ void __launch_bounds__(NTHREADS, 2) fwd(Args args) {
    extern __shared__ __attribute__((aligned(16))) unsigned char lds_raw[];
    LAS unsigned char* lds = (LAS unsigned char*)lds_raw;
    const int tid = threadIdx.x, lane = tid & 63, wave = __builtin_amdgcn_readfirstlane(tid >> 6);
    const int G = gridDim.x; const int bx = blockIdx.x; const int vcu = (G % 8 == 0) ? (bx % 8) * (G / 8) + bx / 8 : bx;
    const int gw = vcu * NWAVES + wave, NGW = G * NWAVES;
    unsigned char* ws = args.ws;
    unsigned* ctl = (unsigned*)(ws + WS_CTL);
    for (int u = tid; u < (LDS_BYTES - MISC_OFF) / 4; u += NTHREADS) ((LAS unsigned*)(lds + MISC_OFF))[u] = 0u;
    __syncthreads();
#if MK_N_LAUNCHES == 1
    XcdBarrier bar = xcd_barrier_post(ctl + CW_BAR, (volatile LAS unsigned*)(lds + MISC_OFF));
#define GRID_BAR() xcd_barrier(bar)
#else
#define GRID_BAR() do {} while (0)
#endif
    const int lo = args.ph_lo, hi = args.ph_hi;
#define IN(k) (lo <= (k) && (k) < hi)
#define SEAM(k) do { if (IN(k) && IN((k) + 1)) GRID_BAR(); } while (0)
    bf16_t* X = (bf16_t*)(ws + WS_X);

    if (IN(0)) {
        ProIn I; I.x = args.in[0]; I.mem = args.in[1]; I.a_w_in = args.in[2]; I.a_w_out = args.in[3]; I.b_w_in = args.in[4]; I.b_q_norm = args.in[5]; I.b_w_qb = args.in[6];
        I.b_kv_norm = args.in[7]; I.b_w_kvb = args.in[8]; I.b_w_out = args.in[9]; I.mem_w_kv = args.in[10]; I.w_grp = args.in[15]; I.w_exp = args.in[17];
        I.w_gate = args.in[19]; I.w_up = args.in[20]; I.w_down = args.in[21];
        prologue_phase(I, ws, lds, gw, NGW, lane);
    }
    SEAM(0);
    if (IN(1)) {
        { const DenseProb P = dense(X, DM, ws + WS_WINA, DM, NTOK, A_IN, DM, G); const EpiProjA E{(bf16_t*)(ws + WS_PROJ), (const f32x2*)(ws + WS_ROPEA)}; pg::gemm_phase(lds, P, E); }
        { const DenseProb P = dense(ws + WS_MEMB, DM, ws + WS_WMEM, DM, NMEM, 1024, DM, G); const EpiPlain E{(bf16_t*)(ws + WS_MEMKV), 1024}; pg::gemm_phase(lds, P, E); }
    }
    SEAM(1);
    if (IN(2)) attn0_phase(ws, lds, vcu, G);
    SEAM(2);
    if (IN(3)) merge_phase(ws, gw, NGW, lane);
    SEAM(3);
    if (IN(4)) { const DenseProb P = dense(ws + WS_CAT, 512, ws + WS_WOUTA, 512, NTOK, DM, 512, G); const EpiPlain E{(bf16_t*)(ws + WS_Y), DM}; pg::gemm_phase(lds, P, E); }
    SEAM(4);
#define MOE_BLOCK(PH, LAYER, FINAL) \
    if (IN((PH) - 1)) ln_mix_phase(ws, args.in[11] + (LAYER) * DM, args.in[12] + (LAYER) * DM, gw, NGW, lane); \
    SEAM((PH) - 1); \
    if (IN(PH)) router_phase(ws, (const bf16_t*)(ws + WS_WR) + (size_t)(LAYER) * 48 * 1024, args.in[16] + (LAYER) * 4, args.in[18] + (LAYER) * 32, lds, vcu, G, wave, lane); \
    SEAM(PH); \
    if (IN((PH) + 1)) assign_phase(ws, lds, vcu, G, wave, lane); \
    SEAM((PH) + 1); \
    if (IN((PH) + 2)) { \
        if (tid <= NEXP) ((LAS int*)(lds + MISC_TSTART))[tid] = ((const int*)(ws + WS_META))[tid]; \
        __syncthreads(); \
        MoeProb P; P.Abase = (const char*)(ws + WS_XB); P.lda_bytes = DM * 2; P.Bt = (const char*)(ws + WS_WGU) + (size_t)(LAYER) * 32 * 1024 * 1024 * 2; P.bexp_bytes = (size_t)1024 * 1024 * 2; P.ldb_bytes = 2048; \
        P.K = DM; P.nM = __builtin_amdgcn_readfirstlane(((LAS int*)(lds + MISC_TSTART))[NEXP]); P.nN = 4; P.G = G; P.c = bx; P.slot_tok = (const int*)(ws + WS_SLOTTOK); P.tstart = (const LAS int*)(lds + MISC_TSTART); \
        const EpiGateUp E{(bf16_t*)(ws + WS_H)}; pg::gemm_phase(lds, P, E); } \
    SEAM((PH) + 2); \
    if (IN((PH) + 3)) { \
        if (tid <= NEXP) ((LAS int*)(lds + MISC_TSTART))[tid] = ((const int*)(ws + WS_META))[tid]; \
        __syncthreads(); \
        MoeProb P; P.Abase = (const char*)(ws + WS_H); P.lda_bytes = DEXP * 2; P.Bt = (const char*)(ws + WS_WD) + (size_t)(LAYER) * 32 * 1024 * 512 * 2; P.bexp_bytes = (size_t)1024 * 512 * 2; P.ldb_bytes = 1024; \
        P.K = DEXP; P.nM = __builtin_amdgcn_readfirstlane(((LAS int*)(lds + MISC_TSTART))[NEXP]); P.nN = 4; P.G = G; P.c = bx; P.slot_tok = nullptr; P.tstart = (const LAS int*)(lds + MISC_TSTART); \
        const EpiPlain E{(bf16_t*)(ws + WS_YS), DM}; pg::gemm_phase(lds, P, E); } \
    SEAM((PH) + 3); \
    if (IN((PH) + 4)) ln_moe_phase<FINAL>(ws, args.in[13] + (LAYER) * DM, args.in[14] + (LAYER) * DM, args.out, gw, NGW, lane);
    MOE_BLOCK(6, 0, false)
    SEAM(10);
    if (IN(11)) { const DenseProb P = dense(X, DM, ws + WS_WINB, DM, NTOK, B_INP, DM, G); const EpiProjB E{(bf16_t*)(ws + WS_PROJB), (const f32x2*)(ws + WS_ROPEB), (float*)(ws + WS_RQ), (float*)(ws + WS_RKV)}; pg::gemm_phase(lds, P, E); }
    SEAM(11);
    if (IN(12)) {
        { const DenseProb P = dense(ws + WS_PROJB, B_INP, ws + WS_WQB, 256, NTOK, 768, 256, G); const EpiQ E{(bf16_t*)(ws + WS_QB), (const f32x2*)(ws + WS_ROPEB), (const float*)(ws + WS_RQ)}; pg::gemm_phase(lds, P, E); }
        { const DenseProb P = dense((const bf16_t*)(ws + WS_PROJB) + 128, B_INP, ws + WS_WKVB, 256, NTOK, 1024, 256, G); const EpiKV E{(bf16_t*)(ws + WS_KV), (const float*)(ws + WS_RKV)}; pg::gemm_phase(lds, P, E); }
    }
    SEAM(12);
    if (IN(13)) attn1_phase(ws, lds, vcu, G);
    SEAM(13);
    if (IN(14)) { const DenseProb P = dense(ws + WS_ATT, 768, ws + WS_WOUTB, 768, NTOK, DM, 768, G); const EpiPlain E{(bf16_t*)(ws + WS_Y), DM}; pg::gemm_phase(lds, P, E); }
    SEAM(14);
    MOE_BLOCK(16, 1, true)
#undef IN
#undef SEAM
}


#ifndef DIAG
#define DIAG 0
#endif
#if DIAG
__global__ void ck_kernel(const unsigned* p, size_t nwords, const int* meta, int rowwords, unsigned long long* out) {
    if (meta) nwords = (size_t)meta[32] * 256 * rowwords;
    unsigned long long a = 0, b = 0;
    for (size_t i = (size_t)blockIdx.x * blockDim.x + threadIdx.x; i < nwords; i += (size_t)gridDim.x * blockDim.x) { const unsigned w = p[i]; a += w; b += (unsigned)(w * 2654435761u) >> 5; }
    for (int o = 32; o >= 1; o >>= 1) { a += __shfl_xor(a, o); b += __shfl_xor(b, o); }
    if ((threadIdx.x & 63) == 0) { atomicAdd(out, a); atomicAdd(out + 1, b); }
}
__global__ void cmp_rows_kernel(const unsigned short* a, const unsigned short* b, unsigned long long* out) {
    const int lane = threadIdx.x & 63; const size_t w = ((size_t)blockIdx.x * blockDim.x + threadIdx.x) >> 6, nw = ((size_t)gridDim.x * blockDim.x) >> 6;
    unsigned long long nr = 0, ne = 0;
    for (size_t row = w; row < (size_t)NTOK; row += nw) { int d = 0; for (int i = lane; i < DM; i += 64) d += a[row * DM + i] != b[row * DM + i];
        for (int o = 32; o >= 1; o >>= 1) d += __shfl_xor(d, o);
        if (d) { nr += 1; ne += d; } }
    if (lane == 0) { atomicAdd(out, nr); atomicAdd(out + 1, ne); }
}
__global__ void enc_kernel(const unsigned long long* sums, float* out, size_t n) {
    int first = -1;
    for (int p = 0; p < 32; ++p) { bool d = false; for (int rep = 1; rep < 3; ++rep) d = d || sums[p * 2] != sums[(rep * 32 + p) * 2] || sums[p * 2 + 1] != sums[(rep * 32 + p) * 2 + 1]; if (d) { first = p; break; } }
    if (first < 0) return;
    const float c = (float)(first + 2);
    for (size_t i = (size_t)blockIdx.x * blockDim.x + threadIdx.x; i < n; i += (size_t)gridDim.x * blockDim.x) out[i] = c;
}
#endif

extern "C" void kernel_launch(void* const* d_in, const int* in_sizes, int n_in, void* d_out, int out_size, void* d_ws, size_t ws_size, hipStream_t stream) {
    static int grid = 0;
    if (grid == 0) {
        if (n_in != 22 || in_sizes[0] != NTOK * DM || out_size != NTOK * DM || ws_size < WS_END) { fprintf(stderr, "kernel_launch: unexpected shapes (n_in %d, ws %zu)\n", n_in, ws_size); grid = -1; return; }
        int dev = 0, cus = 0, per_cu = 0;
        if (hipGetDevice(&dev) != hipSuccess || hipDeviceGetAttribute(&cus, hipDeviceAttributeMultiprocessorCount, dev) != hipSuccess) { grid = -1; return; }
        if (hipFuncSetAttribute((const void*)fwd, hipFuncAttributeMaxDynamicSharedMemorySize, LDS_BYTES) != hipSuccess) { fprintf(stderr, "kernel_launch: hipFuncSetAttribute failed\n"); grid = -1; return; }
        if (hipOccupancyMaxActiveBlocksPerMultiprocessor(&per_cu, (const void*)fwd, NTHREADS, LDS_BYTES) != hipSuccess || per_cu < 1) fprintf(stderr, "kernel_launch: occupancy query says %d\n", per_cu);
        (void)hipGetLastError();
        grid = cus;
    }
    if (grid < 0) return;
    (void)hipMemsetAsync((char*)d_ws + WS_CTL, 0, CTL_ZERO_BYTES, stream);
    Args a{};
    for (int i = 0; i < 22; ++i) a.in[i] = (const float*)d_in[i];
    a.out = (float*)d_out; a.ws = (unsigned char*)d_ws;
#if MK_N_LAUNCHES == 1
    a.ph_lo = 0; a.ph_hi = NPH;
    hipLaunchKernelGGL(fwd, dim3(grid), dim3(NTHREADS), LDS_BYTES, stream, a);
#else
#if DIAG
    unsigned char* ws = (unsigned char*)d_ws; unsigned long long* sums = (unsigned long long*)(ws + WS_CTL + 512 * 1024);
    const int* meta = (const int*)(ws + WS_META);
    (void)hipMemsetAsync(ws + MiB, 0xAA, WS_END - MiB, stream);
#define CK(off, bytes) hipLaunchKernelGGL(ck_kernel, dim3(1024), dim3(256), 0, stream, (const unsigned*)(ws + (off)), (size_t)(bytes) / 4, (const int*)nullptr, 0, sums + (rep * 32 + p) * 2)
#define CKM(off, rowwords) hipLaunchKernelGGL(ck_kernel, dim3(1024), dim3(256), 0, stream, (const unsigned*)(ws + (off)), (size_t)0, meta, (rowwords), sums + (rep * 32 + p) * 2)
    for (int p = 0; p < NPH; ++p) {
        for (int rep = 0; rep < 3; ++rep) {
            a.ph_lo = p; a.ph_hi = p + 1; hipLaunchKernelGGL(fwd, dim3(grid), dim3(NTHREADS), LDS_BYTES, stream, a);
            switch (p) {
            case 0: CK(WS_WINA, 7 * MiB + 896 * 1024); CK(WS_WKVB, 4 * MiB); CK(WS_WR, 192 * 1024); CK(WS_WGU, 192 * MiB); CK(WS_MEMB, 8 * MiB); CK(WS_X, 128 * MiB); CK(WS_ROPEA, 768 * 1024); break;
            case 1: CK(WS_PROJ, 320 * MiB); CK(WS_MEMKV, 8 * MiB); break;
            case 2: CK(WS_OG, 96 * MiB); CK(WS_LSE, 3 * MiB); CK(WS_CAT, 64 * MiB); break;
            case 3: CK(WS_CAT, 64 * MiB); break;
            case 4: case 14: CK(WS_Y, 128 * MiB); break;
            case 5: case 15: CK(WS_XB, 128 * MiB); break;
            case 6: case 16: CK(WS_TOKGW, 1024 * 1024); CK(WS_WGCNT, 32 * 1024); break;
            case 7: case 17: CK(WS_META, 512); break;
            case 8: case 18: CKM(WS_H, 256); break;
            case 9: case 19: CKM(WS_YS, 512); break;
            case 10: CK(WS_X, 128 * MiB); break;
            case 11: CK(WS_PROJB, 96 * MiB); CK(WS_RQ, 2 * MiB); break;
            case 12: CK(WS_QB, 96 * MiB); CK(WS_KV, 128 * MiB); break;
            case 13: CK(WS_ATT, 96 * MiB); break;
            default: hipLaunchKernelGGL(ck_kernel, dim3(1024), dim3(256), 0, stream, (const unsigned*)d_out, (size_t)NTOK * DM, (const int*)nullptr, 0, sums + (rep * 32 + p) * 2); break; } } }
    hipLaunchKernelGGL(enc_kernel, dim3(1024), dim3(256), 0, stream, (const unsigned long long*)sums, (float*)d_out, (size_t)NTOK * DM);
#else
    for (int p = 0; p < NPH; ++p) { a.ph_lo = p; a.ph_hi = p + 1; hipLaunchKernelGGL(fwd, dim3(grid), dim3(NTHREADS), LDS_BYTES, stream, a); }
#endif
#endif
}
```

```cpp
#include <hip/hip_runtime.h>
#include <cstdio>
#include <cstdint>

#ifndef MK_N_LAUNCHES
#define MK_N_LAUNCHES 1
#endif

#define LAS __attribute__((address_space(3)))
#define GAS __attribute__((address_space(1)))
typedef unsigned short bf16_t;
typedef short bf16x8 __attribute__((ext_vector_type(8)));
typedef short s16x4 __attribute__((ext_vector_type(4)));
typedef float f32x2 __attribute__((ext_vector_type(2)));
typedef float f32x4 __attribute__((ext_vector_type(4)));
typedef float f32x16 __attribute__((ext_vector_type(16)));
typedef unsigned u32x2 __attribute__((ext_vector_type(2)));
typedef unsigned u32x4 __attribute__((ext_vector_type(4)));
typedef __bf16 bf16x2_t __attribute__((ext_vector_type(2)));

constexpr int DM = 1024, NB = 16, SEQ = 4096, NTOK = NB * SEQ, MEML = 256, NMEM = NB * MEML;
constexpr int A_IN = 2560, B_IN = 672, B_INP = 768;
constexpr int NEXP = 32, DEXP = 512, MAXTILES = 544, MAXSLOTS = MAXTILES * 256;
constexpr float LN_EPS = 1e-5f, RMS_EPS = 1e-6f, ALPHA = 1.41421356237309515f;
constexpr float LOG2E = 1.4426950408889634f;
constexpr float C2_64 = 0.125f * LOG2E;
constexpr float C2_96 = 0.10206207261596575f * LOG2E;
constexpr int NWAVES = 8, NTHREADS = 512;

constexpr size_t MiB = 1u << 20;
constexpr size_t WS_CTL = 0, CTL_ZERO_BYTES = 1 * MiB;
constexpr size_t WS_ROPEA = 1 * MiB;
constexpr size_t WS_ROPEB = 1 * MiB + 256 * 1024;
constexpr size_t WS_WGCNT = 1 * MiB + 768 * 1024;
constexpr size_t WS_META  = WS_WGCNT + 64 * 1024;
constexpr size_t WS_RQ = 2 * MiB, WS_RKV = 3 * MiB;
constexpr size_t WS_WINA = 4 * MiB, WS_WOUTA = 9 * MiB, WS_WINB = 10 * MiB, WS_WQB = 11 * MiB + 512 * 1024, WS_WKVB = 12 * MiB,
                 WS_WOUTB = 12 * MiB + 512 * 1024, WS_WMEM = 14 * MiB, WS_WR = 16 * MiB;
constexpr size_t WS_WGU = 17 * MiB, WS_WD = 145 * MiB;
constexpr size_t WS_MEMB = 209 * MiB, WS_MEMKV = 217 * MiB;
constexpr size_t WS_TOKSLOT = 225 * MiB, WS_TOKGW = WS_TOKSLOT + 512 * 1024, WS_TOKEID = WS_TOKGW + 512 * 1024, WS_SLOTTOK = WS_TOKEID + 512 * 1024;
constexpr size_t WS_X = 228 * MiB;
constexpr size_t WS_R1 = 356 * MiB, WS_R2 = 676 * MiB;
constexpr size_t WS_PROJ = WS_R1;
constexpr size_t WS_OG = WS_R2, WS_LSE = WS_R2 + 96 * MiB, WS_CAT = WS_R2 + 100 * MiB, WS_Y = WS_R2 + 164 * MiB;
constexpr size_t WS_H = WS_R1, WS_YS = WS_R2;
constexpr size_t WS_PROJB = WS_R1, WS_QB = WS_R1 + 96 * MiB, WS_ATT = WS_R1 + 192 * MiB, WS_KV = WS_R2;
constexpr size_t WS_KPE = WS_R2 + 128 * MiB;
constexpr size_t WS_XB = WS_R1 + 192 * MiB;
constexpr size_t WS_END = 1024 * MiB;
static_assert(WS_SLOTTOK + (size_t)MAXSLOTS * 4 <= WS_X, "map");
static_assert(WS_CAT + (size_t)NTOK * 512 * 2 <= WS_Y && WS_Y + (size_t)NTOK * 1024 * 2 <= WS_END, "map");
static_assert(WS_YS + (size_t)MAXSLOTS * 1024 * 2 <= WS_END && WS_H + (size_t)MAXSLOTS * 512 * 2 <= WS_R2, "map");
static_assert(WS_ATT + (size_t)NTOK * 768 * 2 <= WS_R2 && WS_KV + (size_t)NTOK * 1024 * 2 <= WS_Y, "map");
constexpr int CW_TMO = 0, CW_BAR = 4096, CW_DIAG = 32768;

constexpr int RING_BYTES = 131072;
constexpr int MISC_OFF = RING_BYTES;
constexpr int LDS_BYTES = 147456;

#define LDS_WAIT() asm volatile("s_waitcnt lgkmcnt(0)" ::: "memory")
#define VM_WAIT() asm volatile("s_waitcnt vmcnt(0)" ::: "memory")
__device__ __forceinline__ unsigned pk2(float lo, float hi) { f32x2 v = {lo, hi}; bf16x2_t b = __builtin_convertvector(v, bf16x2_t); return __builtin_bit_cast(unsigned, b); }
__device__ __forceinline__ float bf2f(unsigned short b) { return __uint_as_float(((unsigned)b) << 16); }
__device__ __forceinline__ float bflo(unsigned w) { return __uint_as_float(w << 16); }
__device__ __forceinline__ float bfhi(unsigned w) { return __uint_as_float(w & 0xffff0000u); }
__device__ __forceinline__ float wave_sum(float v) {
#pragma unroll
    for (int o = 1; o < 64; o <<= 1) v += __shfl_xor(v, o);
    return v;
}

#define XB_TMO      128
#define XB_XCNT(j)  (256  + 64 * (j))
#define XB_XSUB(j)  (1280 + 64 * (j))
#define XB_XGEN(j)  (2304 + 64 * (j))
#define XB_TOP      3328
#define XB_TOPGEN   3392
#define XCD_BAR_WORDS 3456
#define XB_SPIN_CAP (1u << 24)
__device__ __forceinline__ unsigned xb_ld(unsigned* p)              { return __hip_atomic_load(p, __ATOMIC_RELAXED, __HIP_MEMORY_SCOPE_AGENT); }
__device__ __forceinline__ unsigned xb_add(unsigned* p, unsigned v) { return __hip_atomic_fetch_add(p, v, __ATOMIC_RELAXED, __HIP_MEMORY_SCOPE_AGENT); }
__device__ __forceinline__ unsigned xb_xcc_id() { return (unsigned)__builtin_amdgcn_s_getreg((3 << 11) | 20) & 0xFu; }
#define XB_SPIN(cond, bar) do { unsigned _sp = 0; while (cond) { __builtin_amdgcn_s_sleep(1); \
    if ((++_sp & 255u) == 0u) { if (xb_ld(&(bar)[XB_TMO])) break; if (_sp > XB_SPIN_CAP) { atomicAdd(&(bar)[XB_TMO], 1u); break; } } } } while (0)
struct XcdBarrier { unsigned* bar; unsigned x; volatile LAS unsigned* st; };
__device__ __forceinline__ XcdBarrier xcd_barrier_post(unsigned* bar, volatile LAS unsigned* st) {
    XcdBarrier b; b.bar = bar; b.x = xb_xcc_id(); b.st = st;
    if (threadIdx.x == 0) (void)xb_add(&bar[XB_XCNT(b.x)], 1u);
    return b;
}
__device__ __forceinline__ void xcd_barrier_complete(unsigned* bar, unsigned x, unsigned& nloc, unsigned& nx) {
    const unsigned G = gridDim.x * gridDim.y * gridDim.z;
    unsigned sum, cnt, mine, sp = 0u;
    for (;;) {
        sum = 0u; cnt = 0u; mine = 0u;
#pragma unroll
        for (unsigned j = 0; j < 16; ++j) { const unsigned c = xb_ld(&bar[XB_XCNT(j)]); sum += c; cnt += (c > 0u) ? 1u : 0u; mine = (j == x) ? c : mine; }
        if (sum == G) break;
        __builtin_amdgcn_s_sleep(1);
        if ((++sp & 255u) == 0u) { if (xb_ld(&bar[XB_TMO])) break; if (sp > XB_SPIN_CAP) { atomicAdd(&bar[XB_TMO], 1u); break; } }
    }
    nloc = mine > 0u ? mine : 1u; nx = cnt > 0u ? cnt : 1u;
}
__device__ __forceinline__ void xcd_barrier(const XcdBarrier& b) {
    asm volatile("s_waitcnt vmcnt(0)" ::: "memory");
    __syncthreads();
    if (threadIdx.x == 0) {
        unsigned* bar = b.bar;
        __builtin_amdgcn_s_waitcnt(0);
        unsigned nloc = b.st[0], nx = b.st[1];
        if (nloc == 0u) { xcd_barrier_complete(bar, b.x, nloc, nx); b.st[0] = nloc; b.st[1] = nx; }
        const unsigned old = xb_add(&bar[XB_XSUB(b.x)], 1u);
        const unsigned gen = old / nloc;
        if (old + 1u == (gen + 1u) * nloc) {
            __builtin_amdgcn_fence(__ATOMIC_RELEASE, "agent");
            asm volatile("s_waitcnt vmcnt(0)" ::: "memory");
            const unsigned og = xb_add(&bar[XB_TOP], 1u);
            const unsigned tg = og / nx;
            if (og + 1u == (tg + 1u) * nx) xb_add(&bar[XB_TOPGEN], 1u);
            else XB_SPIN(xb_ld(&bar[XB_TOPGEN]) == tg, bar);
            __builtin_amdgcn_fence(__ATOMIC_ACQUIRE, "agent");
            xb_add(&bar[XB_XGEN(b.x)], 1u);
            asm volatile("s_waitcnt vmcnt(0)" ::: "memory");
        } else {
            XB_SPIN(xb_ld(&bar[XB_XGEN(b.x)]) == gen, bar);
            __builtin_amdgcn_fence(__ATOMIC_ACQUIRE, "agent");
            asm volatile("s_waitcnt vmcnt(0)" ::: "memory");
        }
    }
    __syncthreads();
}

namespace pg {
constexpr int BM = 256, BK = 64, HALF = 128, HTB = HALF * BK * 2, NXCD = 8, WGM = 8;
__device__ __forceinline__ int lds_byte(int r, int c) { const int st = (r >> 4) * 2 + (c >> 5), rr = r & 15, cc = c & 31, ob = rr * 64 + cc * 2; return st * 1024 + (ob ^ (((ob >> 9) & 1) << 5)); }
__device__ __forceinline__ void stage_rc(int b, int& R, int& C) { const int st = b / 1024, sb = b % 1024, swz = sb ^ (((sb >> 9) & 1) << 5); R = (st >> 1) * 16 + swz / 64; C = (st & 1) * 32 + (swz % 64) / 2; }
__device__ __forceinline__ int perm32(int rho) { const int n = rho >> 4, i = rho & 15; return 8 * (i >> 2) + 4 * n + (i & 3); }
__device__ __forceinline__ bool static_order(int i, int G, int c, int nM, int nN, int& pm, int& pn) {
    const int nwg = nM * nN; const long L = (long)i * G + c; if (L >= nwg) return false;
    int wgid = (int)L; { const int q = nwg / NXCD, r = nwg % NXCD, xcd = wgid % NXCD, off = wgid / NXCD; wgid = (xcd < r ? xcd * (q + 1) : r * (q + 1) + (xcd - r) * q) + off; }
    const int nig = WGM * nN, gid = wgid / nig, fm = gid * WGM, gsz = (nM - fm) < WGM ? (nM - fm) : WGM;
    pm = fm + ((wgid % nig) % gsz); pn = (wgid % nig) / gsz; return true;
}

template <class Prob, class Epi>
__device__ __forceinline__ void gemm_phase(LAS unsigned char* lds, const Prob& P, const Epi& E) {
    typedef typename Prob::Unit Unit;
    const int tid = threadIdx.x, wid = __builtin_amdgcn_readfirstlane(tid >> 6), lane = tid & 63, wr = wid >> 2, wc = wid & 3, fr = lane & 15, fq = lane >> 4;
    const int nt = P.K / BK;
    int Rr[2]; unsigned Cb[2], voffB[2];
#pragma unroll
    for (int i = 0; i < 2; ++i) { int R, C; stage_rc(tid * 16 + i * 8192, R, C); Rr[i] = R; Cb[i] = (unsigned)C * 2u;
        const int Rb = (R & ~31) + perm32(R & 31);
        voffB[i] = (unsigned)Rb * P.ldb_bytes + (unsigned)C * 2u; }
    const size_t kstep = (size_t)(BK * 2);
    const size_t hstepB = (size_t)HALF * P.ldb_bytes;
    const unsigned ldsw = (unsigned)wid * 1024u;
    const int aoff = lds_byte(wr * 64 + fr, fq * 8), boff = lds_byte(wc * 32 + fr, fq * 8);
    const char* const Abase = P.Abase;
#define PG_SA(b, h) (((b) * 2 + (h)) * HTB)
#define PG_SB(b, h) ((4 + (b) * 2 + (h)) * HTB)
#define PG_STAGE(bufoff, gbase, voff) do { _Pragma("unroll") for (int _i = 0; _i < 2; ++_i) \
        __builtin_amdgcn_global_load_lds((const unsigned*)((const char*)(gbase) + (voff)[_i]), (LAS unsigned*)(lds + (bufoff) + ldsw + _i * 8192), 16, 0, 0); } while (0)
#define PG_LDA(dst, b, h) do { _Pragma("unroll") for (int m = 0; m < 4; ++m) _Pragma("unroll") for (int k = 0; k < 2; ++k) dst[m][k] = *(const LAS bf16x8*)(lds + PG_SA(b, h) + aoff + m * 2048 + k * 1024); } while (0)
#define PG_LDB(dst, b, h) do { _Pragma("unroll") for (int n = 0; n < 2; ++n) _Pragma("unroll") for (int k = 0; k < 2; ++k) dst[n][k] = *(const LAS bf16x8*)(lds + PG_SB(b, h) + boff + n * 2048 + k * 1024); } while (0)
#define PG_MMA(ai, bj, At, Bt) do { __builtin_amdgcn_s_setprio(1); _Pragma("unroll") for (int m = 0; m < 4; ++m) _Pragma("unroll") for (int n = 0; n < 2; ++n) _Pragma("unroll") for (int k = 0; k < 2; ++k) \
        acc[ai][bj][m][n] = __builtin_amdgcn_mfma_f32_16x16x32_bf16(Bt[n][k], At[m][k], acc[ai][bj][m][n], 0, 0, 0); __builtin_amdgcn_s_setprio(0); } while (0)
#define PG_WAIT_V(n) asm volatile("s_waitcnt vmcnt(" #n ")" ::: "memory")
#define PG_WAIT_L(n) asm volatile("s_waitcnt lgkmcnt(" #n ")" ::: "memory")
#define PG_BAR __builtin_amdgcn_s_barrier()
#define PG_SCHED __builtin_amdgcn_sched_barrier(0)
    Unit cur, nxt; int ui = 0;
    if (!P.next(0, cur)) return;
    if (P.delay > 0) { const unsigned long long t0 = __builtin_amdgcn_s_memrealtime(); while ((long long)(__builtin_amdgcn_s_memrealtime() - t0) < (long long)P.delay) __builtin_amdgcn_s_sleep(32); }
    f32x4 acc[2][2][4][2];
#pragma unroll
    for (int a = 0; a < 2; ++a)
#pragma unroll
        for (int b = 0; b < 2; ++b)
#pragma unroll
            for (int m = 0; m < 4; ++m)
#pragma unroll
                for (int n = 0; n < 2; ++n) acc[a][b][m][n] = (f32x4){0.f, 0.f, 0.f, 0.f};
    bf16x8 At[4][2], B0[2][2], B1[2][2];
    unsigned aC0[2], aC1[2], aN0[2], aN1[2];
#pragma unroll
    for (int i = 0; i < 2; ++i) { aC0[i] = (unsigned)P.arow(cur, Rr[i]) * P.lda_bytes + Cb[i]; aC1[i] = (unsigned)P.arow(cur, Rr[i] + HALF) * P.lda_bytes + Cb[i]; }
    const char* cB = P.bbase(cur);
    PG_STAGE(PG_SB(0, 0), cB, voffB); PG_STAGE(PG_SB(0, 1), cB + hstepB, voffB); PG_STAGE(PG_SA(0, 0), Abase, aC0); PG_STAGE(PG_SA(0, 1), Abase, aC1);
    if (wr == 1) PG_BAR;
    PG_WAIT_V(2); PG_BAR;
    PG_STAGE(PG_SB(1, 0), cB + kstep, voffB); PG_STAGE(PG_SA(1, 0), Abase + kstep, aC0); PG_STAGE(PG_SB(1, 1), cB + hstepB + kstep, voffB);
    PG_WAIT_V(6); PG_BAR;
    for (;;) {
        const bool has_next = P.next(ui + 1, nxt);
        const char* nB = cB;
#pragma unroll
        for (int i = 0; i < 2; ++i) { aN0[i] = aC0[i]; aN1[i] = aC1[i]; }
        if (has_next) { nB = P.bbase(nxt);
#pragma unroll
            for (int i = 0; i < 2; ++i) { aN0[i] = (unsigned)P.arow(nxt, Rr[i]) * P.lda_bytes + Cb[i]; aN1[i] = (unsigned)P.arow(nxt, Rr[i] + HALF) * P.lda_bytes + Cb[i]; } }
        for (int t = 0; t < nt; t += 2) {
            const bool last = (t == nt - 2);
            const char* a1 = Abase + (size_t)(t + 1) * kstep;
            const char* a2 = last ? Abase : Abase + (size_t)(t + 2) * kstep; const char* b2 = last ? nB : cB + (size_t)(t + 2) * kstep;
            const char* a3 = a2 + kstep; const char* b3 = b2 + kstep;
            unsigned aS0[2], aS1[2];
#pragma unroll
            for (int i = 0; i < 2; ++i) { aS0[i] = last ? aN0[i] : aC0[i]; aS1[i] = last ? aN1[i] : aC1[i]; }
            PG_LDB(B0, 0, 0); PG_LDB(B1, 0, 1); PG_SCHED; PG_LDA(At, 0, 0); PG_STAGE(PG_SA(1, 1), a1, aC1);
            PG_WAIT_V(8); PG_WAIT_L(0); PG_BAR; PG_MMA(0, 0, At, B0); PG_MMA(0, 1, At, B1); PG_BAR; PG_SCHED;
            PG_LDA(At, 0, 1); PG_STAGE(PG_SB(0, 0), b2, voffB); PG_STAGE(PG_SB(0, 1), b2 + hstepB, voffB); PG_STAGE(PG_SA(0, 0), a2, aS0);
            PG_WAIT_V(8); PG_WAIT_L(0); PG_BAR; PG_MMA(1, 0, At, B0); PG_MMA(1, 1, At, B1); PG_BAR; PG_SCHED;
            PG_LDB(B0, 1, 0); PG_LDB(B1, 1, 1); PG_SCHED; PG_LDA(At, 1, 0); PG_STAGE(PG_SA(0, 1), a2, aS1);
            PG_WAIT_V(8); PG_WAIT_L(0); PG_BAR; PG_MMA(0, 0, At, B0); PG_MMA(0, 1, At, B1); PG_BAR; PG_SCHED;
            PG_LDA(At, 1, 1); PG_STAGE(PG_SB(1, 0), b3, voffB); PG_STAGE(PG_SB(1, 1), b3 + hstepB, voffB); PG_STAGE(PG_SA(1, 0), a3, aS0);
            PG_WAIT_V(8); PG_WAIT_L(0); PG_BAR; PG_MMA(1, 0, At, B0); PG_MMA(1, 1, At, B1); PG_BAR; PG_SCHED;
        }
        if (wr == 0) PG_BAR;
        E(acc, cur, wr, wc, fr, fq);
        if (!has_next) break;
#pragma unroll
        for (int a = 0; a < 2; ++a)
#pragma unroll
            for (int b = 0; b < 2; ++b)
#pragma unroll
                for (int m = 0; m < 4; ++m)
#pragma unroll
                    for (int n = 0; n < 2; ++n) acc[a][b][m][n] = (f32x4){0.f, 0.f, 0.f, 0.f};
        cur = nxt; cB = nB; ++ui;
#pragma unroll
        for (int i = 0; i < 2; ++i) { aC0[i] = aN0[i]; aC1[i] = aN1[i]; }
        if (wr == 1) PG_BAR;
    }
    PG_WAIT_V(0);
    PG_BAR;
#undef PG_SA
#undef PG_SB
#undef PG_STAGE
#undef PG_LDA
#undef PG_LDB
#undef PG_MMA
#undef PG_WAIT_V
#undef PG_WAIT_L
#undef PG_BAR
#undef PG_SCHED
}
}

typedef f32x4 AccT[2][2][4][2];
__device__ __forceinline__ void st4(bf16_t* p, f32x4 v) { u32x2 w; w.x = pk2(v[0], v[1]); w.y = pk2(v[2], v[3]); *(u32x2*)p = w; }

struct DenseProb {
    struct Unit { int pm, pn; };
    const char* Abase; unsigned lda_bytes; const char* Bt; unsigned ldb_bytes; int K, nM, nN, G, c, delay;
    __device__ __forceinline__ bool next(int i, Unit& u) const { return pg::static_order(i, G, c, nM, nN, u.pm, u.pn); }
    __device__ __forceinline__ int arow(const Unit& u, int r) const { return u.pm * 256 + r; }
    __device__ __forceinline__ const char* bbase(const Unit& u) const { return Bt + (size_t)u.pn * 256 * ldb_bytes; }
};
struct MoeProb {
    struct Unit { int pm, pn, e; };
    const char* Abase; unsigned lda_bytes; const char* Bt; size_t bexp_bytes; unsigned ldb_bytes; int K, nM, nN, G, c, delay;
    const int* slot_tok; const LAS int* tstart;
    __device__ __forceinline__ bool next(int i, Unit& u) const {
        if (!pg::static_order(i, G, c, nM, nN, u.pm, u.pn)) return false;
        int e = 0;
#pragma unroll 1
        for (int k = 1; k < NEXP; ++k) e += (tstart[k] <= u.pm) ? 1 : 0;
        u.e = __builtin_amdgcn_readfirstlane(e); return true;
    }
    __device__ __forceinline__ int arow(const Unit& u, int r) const { return slot_tok ? slot_tok[u.pm * 256 + r] : u.pm * 256 + r; }
    __device__ __forceinline__ const char* bbase(const Unit& u) const { return Bt + (size_t)u.e * bexp_bytes + (size_t)u.pn * 256 * ldb_bytes; }
};

__device__ __forceinline__ void st8(bf16_t* p, f32x4 a, f32x4 b) { u32x4 w; w.x = pk2(a[0], a[1]); w.y = pk2(a[2], a[3]); w.z = pk2(b[0], b[1]); w.w = pk2(b[2], b[3]); *(u32x4*)p = w; }
__device__ __forceinline__ f32x4 shx4(f32x4 v, int m) { f32x4 o; o[0] = __shfl_xor(v[0], m); o[1] = __shfl_xor(v[1], m); o[2] = __shfl_xor(v[2], m); o[3] = __shfl_xor(v[3], m); return o; }
__device__ __forceinline__ f32x4 rot4(f32x4 a, f32x4 o, f32x4 cs, f32x4 cs2, float sg) {
    f32x4 r; r[0] = a[0] * cs[0] + sg * o[0] * cs[1]; r[1] = a[1] * cs[2] + sg * o[1] * cs[3]; r[2] = a[2] * cs2[0] + sg * o[2] * cs2[1]; r[3] = a[3] * cs2[2] + sg * o[3] * cs2[3]; return r; }
struct EpiPlain {
    bf16_t* O; int ldc;
    template <class U> __device__ __forceinline__ void operator()(const AccT& acc, const U& u, int wr, int wc, int fr, int fq) const {
        const int row0 = u.pm * 256 + wr * 64 + fr, col0 = u.pn * 256 + wc * 32 + 8 * fq;
#pragma unroll
        for (int ai = 0; ai < 2; ++ai)
#pragma unroll
            for (int m = 0; m < 4; ++m) { bf16_t* rowp = O + (size_t)(row0 + ai * 128 + m * 16) * ldc + col0;
#pragma unroll
                for (int bj = 0; bj < 2; ++bj) st8(rowp + bj * 128, acc[ai][bj][m][0], acc[ai][bj][m][1]); }
    }
};
struct EpiProjA {
    bf16_t* O; const f32x2* rope;
    template <class U> __device__ __forceinline__ void operator()(const AccT& acc, const U& u, int wr, int wc, int fr, int fq) const {
        const int row0 = u.pm * 256 + wr * 64 + fr, col0 = u.pn * 256 + wc * 32 + 8 * fq;
        const int region = u.pn / 3;
        const float scale = (region == 0 || region == 3) ? C2_64 : 1.f;
        const bool do_rope = (region <= 1) && ((wc & 1) == 0);
        const float sg = (fq == 0) ? -1.f : (fq == 1) ? 1.f : 0.f;
#pragma unroll
        for (int ai = 0; ai < 2; ++ai)
#pragma unroll
            for (int m = 0; m < 4; ++m) { const int row = row0 + ai * 128 + m * 16; bf16_t* rowp = O + (size_t)row * A_IN + col0;
                f32x4 c0 = {1.f, 0.f, 1.f, 0.f}, c1 = c0, c2 = c0, c3 = c0;
                if (do_rope && fq < 2) { const f32x4* rp = (const f32x4*)(rope + (size_t)(row & (SEQ - 1)) * 8); c0 = rp[0]; c1 = rp[1]; c2 = rp[2]; c3 = rp[3]; }
#pragma unroll
                for (int bj = 0; bj < 2; ++bj) { f32x4 a0 = acc[ai][bj][m][0], a1 = acc[ai][bj][m][1];
                    if (do_rope) { const f32x4 o0 = shx4(a0, 16), o1 = shx4(a1, 16); a0 = rot4(a0, o0, c0, c1, sg); a1 = rot4(a1, o1, c2, c3, sg); }
                    st8(rowp + bj * 128, a0 * scale, a1 * scale); } }
    }
};
struct EpiGateUp {
    bf16_t* H;
    template <class U> __device__ __forceinline__ void operator()(const AccT& acc, const U& u, int wr, int wc, int fr, int fq) const {
        const int row0 = u.pm * 256 + wr * 64 + fr, col0 = u.pn * 128 + wc * 32 + 8 * fq;
#pragma unroll
        for (int ai = 0; ai < 2; ++ai)
#pragma unroll
            for (int m = 0; m < 4; ++m) { bf16_t* rowp = H + (size_t)(row0 + ai * 128 + m * 16) * DEXP + col0; f32x4 h[2];
#pragma unroll
                for (int n = 0; n < 2; ++n) { const f32x4 g = acc[ai][0][m][n], up = acc[ai][1][m][n];
#pragma unroll
                    for (int j = 0; j < 4; ++j) h[n][j] = g[j] / (1.f + __expf(-g[j])) * up[j]; }
                st8(rowp, h[0], h[1]); }
    }
};
struct EpiProjB {
    bf16_t* O; const f32x2* rope; float* RQ; float* RKV; bf16_t* KPE;
    template <class U> __device__ __forceinline__ void operator()(const AccT& acc, const U& u, int wr, int wc, int fr, int fq) const {
        const int row0 = u.pm * 256 + wr * 64 + fr, col0 = u.pn * 256 + wc * 32 + 8 * fq;
#pragma unroll
        for (int ai = 0; ai < 2; ++ai)
#pragma unroll
            for (int m = 0; m < 4; ++m) { const int row = row0 + ai * 128 + m * 16; bf16_t* rowp = O + (size_t)row * B_INP + col0;
                if (u.pn == 0) {
                    float ss = 0.f;
#pragma unroll
                    for (int bj = 0; bj < 2; ++bj) {
#pragma unroll
                        for (int n = 0; n < 2; ++n) { const f32x4 v = acc[ai][bj][m][n]; ss += (v[0] * v[0] + v[1] * v[1]) + (v[2] * v[2] + v[3] * v[3]); }
                        st8(rowp + bj * 128, acc[ai][bj][m][0], acc[ai][bj][m][1]); }
                    ss += __shfl_xor(ss, 16); ss += __shfl_xor(ss, 32);
                    if (fq == 0) RQ[(size_t)row * 4 + wc] = ss;
                } else if (u.pn == 1) {
                    float ss = 0.f;
#pragma unroll
                    for (int n = 0; n < 2; ++n) { const f32x4 v = acc[ai][0][m][n]; ss += (v[0] * v[0] + v[1] * v[1]) + (v[2] * v[2] + v[3] * v[3]); }
                    st8(rowp, acc[ai][0][m][0], acc[ai][0][m][1]);
                    ss += __shfl_xor(ss, 16); ss += __shfl_xor(ss, 32);
                    if (fq == 0) RKV[(size_t)row * 4 + wc] = ss;
                    if (wc == 0) {
                        const f32x4* rp = (const f32x4*)(rope + (size_t)(row & (SEQ - 1)) * 16 + 8 * (fq & 1)); const f32x4 c0 = rp[0], c1 = rp[1], c2 = rp[2], c3 = rp[3];
                        const float sg = (fq < 2) ? -1.f : 1.f;
                        f32x4 a0 = acc[ai][1][m][0], a1 = acc[ai][1][m][1]; const f32x4 o0 = shx4(a0, 32), o1 = shx4(a1, 32);
                        a0 = rot4(a0, o0, c0, c1, sg); a1 = rot4(a1, o1, c2, c3, sg);
                        { const int b = row >> 12, pos = row & (SEQ - 1); st8(KPE + ((size_t)(b * 64 + (pos >> 6)) * 2048 + fq * 512 + (pos & 63) * 8), a0, a1); }
                    } else st8(rowp + 128, acc[ai][1][m][0] * C2_64, acc[ai][1][m][1] * C2_64);
                } else {
#pragma unroll
                    for (int bj = 0; bj < 2; ++bj) st8(rowp + bj * 128, acc[ai][bj][m][0] * C2_64, acc[ai][bj][m][1] * C2_64);
                }
            }
    }
};
struct EpiQ {
    bf16_t* O; const f32x2* rope; const float* RQ;
    template <class U> __device__ __forceinline__ void operator()(const AccT& acc, const U& u, int wr, int wc, int fr, int fq) const {
        const int row0 = u.pm * 256 + wr * 64 + fr, col0 = u.pn * 256 + wc * 32 + 8 * fq;
        const float sg = (fq < 2) ? -1.f : 1.f;
#pragma unroll
        for (int ai = 0; ai < 2; ++ai)
#pragma unroll
            for (int m = 0; m < 4; ++m) { const int row = row0 + ai * 128 + m * 16; bf16_t* rowp = O + (size_t)row * 768 + col0;
                const f32x4 q4 = *(const f32x4*)(RQ + (size_t)row * 4);
                const float rs = (1.0f / sqrtf(((q4[0] + q4[1]) + (q4[2] + q4[3])) * (1.f / 256.f) + RMS_EPS)) * C2_96;
                const f32x4* rp = (const f32x4*)(rope + (size_t)(row & (SEQ - 1)) * 16 + 8 * (fq & 1)); const f32x4 c0 = rp[0], c1 = rp[1], c2 = rp[2], c3 = rp[3];
#pragma unroll
                for (int bj = 0; bj < 2; ++bj) { const int grp = u.pn * 8 + bj * 4 + wc; f32x4 a0 = acc[ai][bj][m][0] * rs, a1 = acc[ai][bj][m][1] * rs;
                    if (grp % 3 == 2) { const f32x4 o0 = shx4(a0, 32), o1 = shx4(a1, 32); a0 = rot4(a0, o0, c0, c1, sg); a1 = rot4(a1, o1, c2, c3, sg); }
                    st8(rowp + bj * 128, a0, a1); } }
    }
};
struct EpiKV {
    bf16_t* O; const float* RKV;
    template <class U> __device__ __forceinline__ void operator()(const AccT& acc, const U& u, int wr, int wc, int fr, int fq) const {
        const int row0 = u.pm * 256 + wr * 64 + fr;
#pragma unroll
        for (int ai = 0; ai < 2; ++ai)
#pragma unroll
            for (int m = 0; m < 4; ++m) { const int row = row0 + ai * 128 + m * 16; const int b = row >> 12, pos = row & (SEQ - 1), tile = pos >> 6, key = pos & 63;
                const f32x4 q4 = *(const f32x4*)(RKV + (size_t)row * 4);
                const float rs = 1.0f / sqrtf(((q4[0] + q4[1]) + (q4[2] + q4[3])) * (1.f / 128.f) + RMS_EPS);
#pragma unroll
                for (int bj = 0; bj < 2; ++bj) { const int h = u.pn * 2 + bj, within = wc * 32 + 8 * fq;
                    const size_t tb = ((size_t)(b * 8 + h) * 64 + tile) * 8192;
                    const size_t off = within < 64 ? (size_t)(within >> 3) * 512 + key * 8 : (size_t)4096 + (size_t)((within - 64) >> 5) * 2048 + key * 32 + ((within - 64) & 31);
                    st8(O + tb + off, acc[ai][bj][m][0] * rs, acc[ai][bj][m][1] * rs); } }
    }
};
struct EpiMemKV {
    bf16_t* O;
    template <class U> __device__ __forceinline__ void operator()(const AccT& acc, const U& u, int wr, int wc, int fr, int fq) const {
        const int row0 = u.pm * 256 + wr * 64 + fr;
#pragma unroll
        for (int ai = 0; ai < 2; ++ai)
#pragma unroll
            for (int m = 0; m < 4; ++m) { const int row = row0 + ai * 128 + m * 16; const int b = row >> 8, mm = row & 255, tile = mm >> 6, key = mm & 63;
#pragma unroll
                for (int bj = 0; bj < 2; ++bj) { const int col = u.pn * 256 + bj * 128 + wc * 32 + 8 * fq; const int layer = col >> 9, two = (col >> 8) & 1, h = (col >> 6) & 3, d = col & 63;
                    const size_t tb = ((size_t)((layer * 16 + b) * 4 + h) * 4 + tile) * 8192;
                    const size_t off = two ? (size_t)4096 + (size_t)(d >> 5) * 2048 + key * 32 + (d & 31) : (size_t)(d >> 3) * 512 + key * 8;
                    st8(O + tb + off, acc[ai][bj][m][0], acc[ai][bj][m][1]); } }
    }
};

__device__ __forceinline__ void glds16(const void* gsrc, unsigned lds_dst) { unsigned keep;
    asm volatile("s_mov_b32 %0, m0\n\ts_mov_b32 m0, %2\n\ts_nop 0\n\tglobal_load_lds_dwordx4 %1, off\n\ts_mov_b32 m0, %0" : "=&s"(keep) : "v"(gsrc), "s"(lds_dst) : "memory"); }
struct AttnJob {
    const bf16_t* Q; const bf16_t* K0; const bf16_t* K1; const bf16_t* V; bf16_t* O; float* LSE;
    int qs, k0s, k1s, vs, os, lses;
    int q0;
    int kt_lo, kt_hi;
    int tiled;
};
constexpr int ATT_KVB = 20480, ATT_WSF = 2 * ATT_KVB, ATT_OST = ATT_WSF + 2048, ATT_LDS = ATT_OST + 8 * 4096;
static_assert(ATT_LDS <= RING_BYTES, "attention LDS");
__device__ __forceinline__ int crow(int r, int hi) { return (r & 3) + 8 * (r >> 2) + 4 * hi; }
__device__ __forceinline__ float max3f(float a, float b, float c) { return __builtin_fmaxf(__builtin_fmaxf(a, b), c); }
typedef short v4i16_t __attribute__((ext_vector_type(4)));
__device__ __forceinline__ s16x4 vtr(const LAS unsigned char* p) { return __builtin_bit_cast(s16x4, __builtin_amdgcn_ds_read_tr16_b64_v4i16((LAS v4i16_t*)p)); }

#ifndef ATT_STAG
#define ATT_STAG 0
#endif
#ifndef ATT_PIPE
#define ATT_PIPE 1
#endif
#ifndef ATT_DBLDMA
#define ATT_DBLDMA 0
#endif
template <int DQC, bool BANDED, bool WLSE>
__device__ __forceinline__ void attn_unit(const AttnJob& J, LAS unsigned char* lds) {
    constexpr bool STAG = ATT_STAG != 0;
    const int tid = threadIdx.x, lane = tid & 63, r32 = lane & 31, hi = lane >> 5; const int wid = __builtin_amdgcn_readfirstlane(tid >> 6);
    constexpr int KBYTES = DQC * 2 * 1024, VOFF = 2 * KBYTES;
    static_assert(VOFF + 16384 <= ATT_WSF, "attention LDS map");
    constexpr float NEG = -1e30f, THR = 6.0f;
    const bool grpB = STAG && wid >= 4;
    LAS float* wsf = (LAS float*)(lds + ATT_WSF) + wid * 64;
    const bf16_t* ksrcA = J.K0 + (size_t)lane * J.k0s + wid * 8;
    const bf16_t* ksrcB = (DQC > 4) ? (J.K1 + (size_t)lane * J.k1s + wid * 8) : ksrcA;
    const bf16_t* vsrc = J.V + (size_t)(16 * (wid & 3) + (lane >> 2)) * J.vs + (wid >> 2) * 32 + (lane & 3) * 8;
#define ATT_STAGE_K(t, kb) do { \
        glds16(ksrcA + (size_t)(t) * 64 * J.k0s, (unsigned)__builtin_amdgcn_readfirstlane((unsigned)(uintptr_t)(lds + (kb) * KBYTES + wid * 1024))); \
        if (DQC > 4 && wid < 2 * DQC - 8) glds16(ksrcB + (size_t)(t) * 64 * J.k1s, (unsigned)__builtin_amdgcn_readfirstlane((unsigned)(uintptr_t)(lds + (kb) * KBYTES + (8 + wid) * 1024))); } while (0)
#define ATT_STAGE_V(t, vb) glds16(vsrc + (size_t)(t) * 64 * J.vs, (unsigned)__builtin_amdgcn_readfirstlane((unsigned)(uintptr_t)(lds + VOFF + (vb) * 8192 + wid * 1024)))
    ATT_STAGE_K(J.kt_lo, 0);
    if (!STAG) ATT_STAGE_V(J.kt_lo, 0);
    bf16x8 qr[DQC];
    { const bf16_t* qp = J.Q + (size_t)(wid * 32 + r32) * J.qs + hi * 8;
#pragma unroll
      for (int d0 = 0; d0 < DQC; ++d0) qr[d0] = *(const bf16x8*)(qp + d0 * 16); }
    float m_run = 0.f, l_run = 0.f; f32x16 o[2], p0, p1, negm; bf16x8 pa[4]; bool first = true;
#pragma unroll
    for (int r = 0; r < 16; ++r) { o[0][r] = 0.f; o[1][r] = 0.f; p0[r] = 0.f; p1[r] = 0.f; negm[r] = 0.f; }
    asm volatile("" : "+v"(negm));
#pragma unroll
    for (int ks = 0; ks < 4; ++ks) pa[ks] = (bf16x8){0, 0, 0, 0, 0, 0, 0, 0};
    const int qi = J.q0 + wid * 32 + r32;
    const int ta = (J.q0 + wid * 32) >> 6;
    const int vlane = ((lane >> 4) & 1) * 32 + (lane & 3) * 8 + (4 * hi + ((lane & 15) >> 2)) * 64;
#define ATT_ACT(t) (!BANDED || ((t) >= ta - 1 && (t) <= ta + 1))
#define ATT_Q(t, kb) do { const LAS unsigned char* kbp = lds + (kb) * KBYTES + hi * 1024 + r32 * 16; \
        { const bf16x8 k0f = *(const LAS bf16x8*)(kbp), k1f = *(const LAS bf16x8*)(kbp + 512); \
          p0 = __builtin_amdgcn_mfma_f32_32x32x16_bf16(k0f, qr[0], negm, 0, 0, 0); \
          p1 = __builtin_amdgcn_mfma_f32_32x32x16_bf16(k1f, qr[0], negm, 0, 0, 0); } \
        _Pragma("unroll") for (int d0 = 1; d0 < DQC; ++d0) { \
            const bf16x8 k0f = *(const LAS bf16x8*)(kbp + d0 * 2048), k1f = *(const LAS bf16x8*)(kbp + d0 * 2048 + 512); \
            p0 = __builtin_amdgcn_mfma_f32_32x32x16_bf16(k0f, qr[d0], p0, 0, 0, 0); \
            p1 = __builtin_amdgcn_mfma_f32_32x32x16_bf16(k1f, qr[d0], p1, 0, 0, 0); } \
        if (BANDED) { const int kb0 = (t) * 64 + 4 * hi - qi; \
            _Pragma("unroll") for (int r = 0; r < 16; ++r) { const int dk = kb0 + (r & 3) + 8 * (r >> 2); \
                if (dk > 64 || dk < -64) p0[r] = NEG; \
                if (dk + 32 > 64 || dk + 32 < -64) p1[r] = NEG; } } } while (0)
#define ATT_S() do { float rm; \
        { float a = max3f(p0[0], p0[1], p1[0]), c = max3f(p0[2], p0[3], p1[1]); a = max3f(a, p1[2], p1[3]); \
          _Pragma("unroll") for (int r = 4; r < 16; r += 4) { a = max3f(a, p0[r], p0[r + 1]); c = max3f(c, p0[r + 2], p0[r + 3]); a = max3f(a, p1[r], p1[r + 1]); c = max3f(c, p1[r + 2], p1[r + 3]); } \
          rm = __builtin_fmaxf(a, c); \
          auto rr = __builtin_amdgcn_permlane32_swap(__float_as_uint(rm), __float_as_uint(rm), false, false); \
          rm = __builtin_fmaxf(__uint_as_float(rr[0]), __uint_as_float(rr[1])); } \
        if (first || __any(rm > THR)) { \
            const float dl = first ? rm : __builtin_fmaxf(rm, 0.f); \
            m_run += dl; \
            _Pragma("unroll") for (int r = 0; r < 16; ++r) { p0[r] -= dl; p1[r] -= dl; negm[r] = -m_run; } \
            asm volatile("" : "+v"(negm)); \
            if (!first) { const float f = __builtin_amdgcn_exp2f(-dl); l_run *= f; \
                if (hi == 0) wsf[r32] = f; \
                LDS_WAIT(); \
                _Pragma("unroll") for (int g = 0; g < 4; ++g) { const f32x4 fv = *(const LAS f32x4*)(wsf + 8 * g + 4 * hi); \
                    _Pragma("unroll") for (int j = 0; j < 4; ++j) { o[0][4 * g + j] *= fv[j]; o[1][4 * g + j] *= fv[j]; } } } \
            first = false; } \
        float sacc = 0.f; \
        _Pragma("unroll") for (int r = 0; r < 16; ++r) { p0[r] = __builtin_amdgcn_exp2f(p0[r]); p1[r] = __builtin_amdgcn_exp2f(p1[r]); sacc += p0[r] + p1[r]; } \
        l_run += sacc; \
        _Pragma("unroll") for (int ks = 0; ks < 4; ++ks) { u32x4 w; \
            _Pragma("unroll") for (int jj = 0; jj < 4; ++jj) { const int r = 8 * (ks & 1) + 2 * jj; w[jj] = (ks < 2) ? pk2(p0[r], p0[r + 1]) : pk2(p1[r], p1[r + 1]); } \
            pa[ks] = __builtin_bit_cast(bf16x8, w); } } while (0)
#define ATT_P(vb) do { const LAS unsigned char* vbp = lds + VOFF + (vb) * 8192 + vlane; \
        _Pragma("unroll") for (int dh = 0; dh < 2; ++dh) \
            _Pragma("unroll") for (int ks = 0; ks < 4; ++ks) { \
                const s16x4 lo = vtr(vbp + dh * 4096 + ks * 1024), hi4 = vtr(vbp + dh * 4096 + ks * 1024 + 512); \
                const bf16x8 vf = (bf16x8){lo[0], lo[1], lo[2], lo[3], hi4[0], hi4[1], hi4[2], hi4[3]}; \
                o[dh] = __builtin_amdgcn_mfma_f32_32x32x16_bf16(pa[ks], vf, o[dh], 0, 0, 0); } } while (0)
    const int NT = J.kt_hi - J.kt_lo;
    VM_WAIT(); __syncthreads();
    for (int i = 0; i < NT; ++i) {
        const int t = J.kt_lo + i;
        if (i + 1 < NT) ATT_STAGE_K(t + 1, (i + 1) & 1);
        if (STAG) ATT_STAGE_V(t, i & 1); else if (i + 1 < NT) ATT_STAGE_V(t + 1, (i + 1) & 1);
        if (ATT_DBLDMA && !BANDED) { if (i + 1 < NT) ATT_STAGE_K(t + 1, (i + 1) & 1); if (i + 1 < NT) ATT_STAGE_V(t + 1, (i + 1) & 1); }
        if (!STAG) {
            if (ATT_ACT(t)) { ATT_Q(t, i & 1); ATT_S(); ATT_P(i & 1); }
        } else if (!grpB) {
            if (i > 0 && ATT_ACT(t - 1)) ATT_P((i - 1) & 1);
            if (ATT_ACT(t)) { ATT_Q(t, i & 1); ATT_S(); }
        } else {
            if (i > 0 && ATT_ACT(t - 1)) { ATT_S(); ATT_P((i - 1) & 1); }
            if (ATT_ACT(t)) ATT_Q(t, i & 1);
        }
        VM_WAIT(); __syncthreads();
    }
    if (STAG) { if (ATT_ACT(J.kt_hi - 1)) { if (grpB) ATT_S(); ATT_P((NT - 1) & 1); } }
    { auto rr = __builtin_amdgcn_permlane32_swap(__float_as_uint(l_run), __float_as_uint(l_run), false, false); l_run = __uint_as_float(rr[0]) + __uint_as_float(rr[1]); }
    if (hi == 0) wsf[32 + r32] = l_run;
    if (WLSE) { if (hi == 0) J.LSE[(size_t)(wid * 32 + r32) * J.lses] = m_run + __log2f(l_run); }
    LDS_WAIT();
    LAS bf16_t* stg = (LAS bf16_t*)(lds + ATT_OST) + wid * 2048;
#pragma unroll
    for (int g = 0; g < 4; ++g) { const f32x4 lv = *(const LAS f32x4*)(wsf + 32 + 8 * g + 4 * hi);
#pragma unroll
        for (int j = 0; j < 4; ++j) { const int r = 4 * g + j; const float rl = 1.0f / lv[j]; const int orow = crow(r, hi);
            stg[orow * 64 + r32] = (bf16_t)(pk2(o[0][r] * rl, 0.f) & 0xffffu); stg[orow * 64 + 32 + r32] = (bf16_t)(pk2(o[1][r] * rl, 0.f) & 0xffffu); } }
    LDS_WAIT();
    bf16_t* Ow = J.O + (size_t)(wid * 32) * J.os;
#pragma unroll
    for (int i = 0; i < 4; ++i) { const int row = i * 8 + (lane >> 3), ch = lane & 7; const u32x4 v = *(const LAS u32x4*)(stg + row * 64 + ch * 8); *(u32x4*)(Ow + (size_t)row * J.os + ch * 8) = v; }
    LDS_WAIT(); __syncthreads();
#undef ATT_STAGE_K
#undef ATT_STAGE_V
#undef ATT_ACT
#undef ATT_Q
#undef ATT_S
#undef ATT_P
}

constexpr int AT2_WSF = 81920, AT2_OST = AT2_WSF + 2048;
static_assert(AT2_OST + 8 * 4096 <= RING_BYTES, "attention LDS");
template <int DQC>
__device__ __forceinline__ void attn_unit_d2(const AttnJob& J, LAS unsigned char* lds) {
    const int tid = threadIdx.x, lane = tid & 63, r32 = lane & 31, hi = lane >> 5; const int wid = __builtin_amdgcn_readfirstlane(tid >> 6);
    constexpr int KBYTES = DQC * 2 * 1024, BUFB = KBYTES + 8192;
    static_assert(3 * BUFB <= AT2_WSF, "attention LDS map");
    constexpr float THR = 6.0f;
    LAS float* wsf = (LAS float*)(lds + AT2_WSF) + wid * 64;
    const bf16_t* ksrcA = J.K0 + (size_t)lane * J.k0s + wid * 8;
    const bf16_t* ksrcB = (DQC > 4) ? (J.K1 + (size_t)lane * J.k1s + wid * 8) : ksrcA;
    const bf16_t* vsrc = J.V + (size_t)(16 * (wid & 3) + (lane >> 2)) * J.vs + (wid >> 2) * 32 + (lane & 3) * 8;
    const bool three = (DQC > 4) && (wid < 2 * DQC - 8);
    const unsigned lds0 = (unsigned)(uintptr_t)lds;
#define D2_STAGE(t, boff) do { \
        glds16(ksrcA + (size_t)(t) * 64 * J.k0s, (unsigned)__builtin_amdgcn_readfirstlane(lds0 + (boff) + wid * 1024)); \
        if (three) glds16(ksrcB + (size_t)(t) * 64 * J.k1s, (unsigned)__builtin_amdgcn_readfirstlane(lds0 + (boff) + (8 + wid) * 1024)); \
        glds16(vsrc + (size_t)(t) * 64 * J.vs, (unsigned)__builtin_amdgcn_readfirstlane(lds0 + (boff) + KBYTES + wid * 1024)); } while (0)
#define D2_WAIT_KEEP1() do { if (three) asm volatile("s_waitcnt vmcnt(3)" ::: "memory"); else asm volatile("s_waitcnt vmcnt(2)" ::: "memory"); } while (0)
#define D2_BAR() do { asm volatile("s_waitcnt lgkmcnt(0)" ::: "memory"); __builtin_amdgcn_s_barrier(); asm volatile("" ::: "memory"); } while (0)
    const int NT = J.kt_hi - J.kt_lo;
    bf16x8 qr[DQC];
    { const bf16_t* qp = J.Q + (size_t)(wid * 32 + r32) * J.qs + hi * 8;
#pragma unroll
      for (int d0 = 0; d0 < DQC; ++d0) qr[d0] = *(const bf16x8*)(qp + d0 * 16); }
    asm volatile("s_waitcnt vmcnt(0)" ::: "memory");
    D2_STAGE(J.kt_lo, 0);
    if (NT > 1) { D2_STAGE(J.kt_lo + 1, BUFB); D2_WAIT_KEEP1(); } else asm volatile("s_waitcnt vmcnt(0)" ::: "memory");
    D2_BAR();
    float m_run = 0.f, l_run = 0.f; f32x16 o[2], p0, p1, negm; bf16x8 pa[4]; bool first = true;
#pragma unroll
    for (int r = 0; r < 16; ++r) { o[0][r] = 0.f; o[1][r] = 0.f; negm[r] = 0.f; }
    asm volatile("" : "+v"(negm));
    const int vlane = ((lane >> 4) & 1) * 32 + (lane & 3) * 8 + (4 * hi + ((lane & 15) >> 2)) * 64;
    int bcur = 0, bnxt2 = 2 * BUFB;
    for (int i = 0; i < NT; ++i) {
        const int t = J.kt_lo + i;
        if (i + 2 < NT) D2_STAGE(t + 2, bnxt2);
        { const LAS unsigned char* kbp = lds + bcur + hi * 1024 + r32 * 16; bf16x8 kf[2 * DQC];
#pragma unroll
          for (int g = 0; g < 2 * DQC; ++g) kf[g] = *(const LAS bf16x8*)(kbp + (g >> 1) * 2048 + (g & 1) * 512);
          __builtin_amdgcn_sched_barrier(0);
          p0 = __builtin_amdgcn_mfma_f32_32x32x16_bf16(kf[0], qr[0], negm, 0, 0, 0);
          p1 = __builtin_amdgcn_mfma_f32_32x32x16_bf16(kf[1], qr[0], negm, 0, 0, 0);
#pragma unroll
          for (int d0 = 1; d0 < DQC; ++d0) {
              p0 = __builtin_amdgcn_mfma_f32_32x32x16_bf16(kf[2 * d0], qr[d0], p0, 0, 0, 0);
              p1 = __builtin_amdgcn_mfma_f32_32x32x16_bf16(kf[2 * d0 + 1], qr[d0], p1, 0, 0, 0); } }
        { float rm;
          { float a = max3f(p0[0], p0[1], p1[0]), c = max3f(p0[2], p0[3], p1[1]); a = max3f(a, p1[2], p1[3]);
#pragma unroll
            for (int r = 4; r < 16; r += 4) { a = max3f(a, p0[r], p0[r + 1]); c = max3f(c, p0[r + 2], p0[r + 3]); a = max3f(a, p1[r], p1[r + 1]); c = max3f(c, p1[r + 2], p1[r + 3]); }
            rm = __builtin_fmaxf(a, c);
            auto rr = __builtin_amdgcn_permlane32_swap(__float_as_uint(rm), __float_as_uint(rm), false, false);
            rm = __builtin_fmaxf(__uint_as_float(rr[0]), __uint_as_float(rr[1])); }
          if (first || __any(rm > THR)) {
              const float dl = first ? rm : __builtin_fmaxf(rm, 0.f);
              m_run += dl;
#pragma unroll
              for (int r = 0; r < 16; ++r) { p0[r] -= dl; p1[r] -= dl; negm[r] = -m_run; }
              asm volatile("" : "+v"(negm));
              if (!first) { const float f = __builtin_amdgcn_exp2f(-dl); l_run *= f;
                  if (hi == 0) wsf[r32] = f;
                  LDS_WAIT();
#pragma unroll
                  for (int g = 0; g < 4; ++g) { const f32x4 fv = *(const LAS f32x4*)(wsf + 8 * g + 4 * hi);
#pragma unroll
                      for (int j = 0; j < 4; ++j) { o[0][4 * g + j] *= fv[j]; o[1][4 * g + j] *= fv[j]; } } }
              first = false; }
          float sacc = 0.f;
#pragma unroll
          for (int r = 0; r < 16; ++r) { p0[r] = __builtin_amdgcn_exp2f(p0[r]); p1[r] = __builtin_amdgcn_exp2f(p1[r]); sacc += p0[r] + p1[r]; }
          l_run += sacc;
#pragma unroll
          for (int ks = 0; ks < 4; ++ks) { u32x4 w;
#pragma unroll
              for (int jj = 0; jj < 4; ++jj) { const int r = 8 * (ks & 1) + 2 * jj; w[jj] = (ks < 2) ? pk2(p0[r], p0[r + 1]) : pk2(p1[r], p1[r + 1]); }
              pa[ks] = __builtin_bit_cast(bf16x8, w); } }
        { const LAS unsigned char* vbp = lds + bcur + KBYTES + vlane;
#pragma unroll
          for (int dh = 0; dh < 2; ++dh)
#pragma unroll
              for (int ks = 0; ks < 4; ++ks) {
                  const s16x4 lo = vtr(vbp + dh * 4096 + ks * 1024), hi4 = vtr(vbp + dh * 4096 + ks * 1024 + 512);
                  const bf16x8 vf = (bf16x8){lo[0], lo[1], lo[2], lo[3], hi4[0], hi4[1], hi4[2], hi4[3]};
                  o[dh] = __builtin_amdgcn_mfma_f32_32x32x16_bf16(pa[ks], vf, o[dh], 0, 0, 0); } }
        if (i + 2 < NT) D2_WAIT_KEEP1(); else asm volatile("s_waitcnt vmcnt(0)" ::: "memory");
        D2_BAR();
        { const int nb = (bcur == 2 * BUFB) ? 0 : bcur + BUFB; bnxt2 = bcur; bcur = nb; }
    }
    { auto rr = __builtin_amdgcn_permlane32_swap(__float_as_uint(l_run), __float_as_uint(l_run), false, false); l_run = __uint_as_float(rr[0]) + __uint_as_float(rr[1]); }
    if (hi == 0) wsf[32 + r32] = l_run;
    LDS_WAIT();
    LAS bf16_t* stg = (LAS bf16_t*)(lds + AT2_OST) + wid * 2048;
#pragma unroll
    for (int g = 0; g < 4; ++g) { const f32x4 lv = *(const LAS f32x4*)(wsf + 32 + 8 * g + 4 * hi);
#pragma unroll
        for (int j = 0; j < 4; ++j) { const int r = 4 * g + j; const float rl = 1.0f / lv[j]; const int orow = crow(r, hi);
            stg[orow * 64 + r32] = (bf16_t)(pk2(o[0][r] * rl, 0.f) & 0xffffu); stg[orow * 64 + 32 + r32] = (bf16_t)(pk2(o[1][r] * rl, 0.f) & 0xffffu); } }
    LDS_WAIT();
    bf16_t* Ow = J.O + (size_t)(wid * 32) * J.os;
#pragma unroll
    for (int q = 0; q < 4; ++q) { const int row = q * 8 + (lane >> 3), ch = lane & 7; const u32x4 v = *(const LAS u32x4*)(stg + row * 64 + ch * 8); *(u32x4*)(Ow + (size_t)row * J.os + ch * 8) = v; }
    asm volatile("s_waitcnt vmcnt(0) lgkmcnt(0)" ::: "memory"); __builtin_amdgcn_s_barrier(); asm volatile("" ::: "memory");
#undef D2_STAGE
#undef D2_WAIT_KEEP1
#undef D2_BAR
}

template <int DQC>
__device__ __forceinline__ void attn_unit2(const AttnJob& J, LAS unsigned char* lds) {
    const int tid = threadIdx.x, lane = tid & 63, r32 = lane & 31, hi = lane >> 5; const int wid = __builtin_amdgcn_readfirstlane(tid >> 6);
    constexpr int KBYTES = DQC * 2 * 1024, SETB = 2 * KBYTES + 16384;
    static_assert(2 * SETB <= AT2_WSF, "attention LDS map");
    constexpr float THR = 6.0f;
    LAS float* wsf = (LAS float*)(lds + AT2_WSF) + wid * 64;
    const bf16_t* ksrcA = J.K0 + (size_t)lane * J.k0s + wid * 8;
    const bf16_t* ksrcB = (DQC > 4) ? (J.K1 + (size_t)lane * J.k1s + wid * 8) : ksrcA;
    const bf16_t* vsrc = J.V + (size_t)(16 * (wid & 3) + (lane >> 2)) * J.vs + (wid >> 2) * 32 + (lane & 3) * 8;
#define A2_STAGE(t, set, which) do { \
        glds16(ksrcA + (size_t)(t) * 64 * J.k0s, (unsigned)__builtin_amdgcn_readfirstlane((unsigned)(uintptr_t)(lds + (set) * SETB + (which) * KBYTES + wid * 1024))); \
        if (DQC > 4 && wid < 2 * DQC - 8) glds16(ksrcB + (size_t)(t) * 64 * J.k1s, (unsigned)__builtin_amdgcn_readfirstlane((unsigned)(uintptr_t)(lds + (set) * SETB + (which) * KBYTES + (8 + wid) * 1024))); \
        glds16(vsrc + (size_t)(t) * 64 * J.vs, (unsigned)__builtin_amdgcn_readfirstlane((unsigned)(uintptr_t)(lds + (set) * SETB + 2 * KBYTES + (which) * 8192 + wid * 1024))); } while (0)
    A2_STAGE(J.kt_lo, 0, 0); A2_STAGE(J.kt_lo + 1, 0, 1);
    bf16x8 qr[DQC];
    { const bf16_t* qp = J.Q + (size_t)(wid * 32 + r32) * J.qs + hi * 8;
#pragma unroll
      for (int d0 = 0; d0 < DQC; ++d0) qr[d0] = *(const bf16x8*)(qp + d0 * 16); }
    float m_run = 0.f, l_run = 0.f; f32x16 o[2], pA0, pA1, pB0, pB1, negm; bf16x8 paA[4], paB[4]; bool first = true;
#pragma unroll
    for (int r = 0; r < 16; ++r) { o[0][r] = 0.f; o[1][r] = 0.f; negm[r] = 0.f; }
    asm volatile("" : "+v"(negm));
    const int vlane = ((lane >> 4) & 1) * 32 + (lane & 3) * 8 + (4 * hi + ((lane & 15) >> 2)) * 64;
#define A2_Q(P0, P1, kbase) do { const LAS unsigned char* kbp = lds + (kbase) + hi * 1024 + r32 * 16; \
        { const bf16x8 k0f = *(const LAS bf16x8*)(kbp), k1f = *(const LAS bf16x8*)(kbp + 512); \
          P0 = __builtin_amdgcn_mfma_f32_32x32x16_bf16(k0f, qr[0], negm, 0, 0, 0); \
          P1 = __builtin_amdgcn_mfma_f32_32x32x16_bf16(k1f, qr[0], negm, 0, 0, 0); } \
        _Pragma("unroll") for (int d0 = 1; d0 < DQC; ++d0) { \
            const bf16x8 k0f = *(const LAS bf16x8*)(kbp + d0 * 2048), k1f = *(const LAS bf16x8*)(kbp + d0 * 2048 + 512); \
            P0 = __builtin_amdgcn_mfma_f32_32x32x16_bf16(k0f, qr[d0], P0, 0, 0, 0); \
            P1 = __builtin_amdgcn_mfma_f32_32x32x16_bf16(k1f, qr[d0], P1, 0, 0, 0); } } while (0)
#define A2_S(P0, P1, PA, Q0, Q1, HAS_OTHER) do { float rm; \
        { float a = max3f(P0[0], P0[1], P1[0]), c = max3f(P0[2], P0[3], P1[1]); a = max3f(a, P1[2], P1[3]); \
          _Pragma("unroll") for (int r = 4; r < 16; r += 4) { a = max3f(a, P0[r], P0[r + 1]); c = max3f(c, P0[r + 2], P0[r + 3]); a = max3f(a, P1[r], P1[r + 1]); c = max3f(c, P1[r + 2], P1[r + 3]); } \
          rm = __builtin_fmaxf(a, c); \
          auto rr = __builtin_amdgcn_permlane32_swap(__float_as_uint(rm), __float_as_uint(rm), false, false); \
          rm = __builtin_fmaxf(__uint_as_float(rr[0]), __uint_as_float(rr[1])); } \
        if (first || __any(rm > THR)) { \
            const float dl = first ? rm : __builtin_fmaxf(rm, 0.f); \
            m_run += dl; \
            _Pragma("unroll") for (int r = 0; r < 16; ++r) { P0[r] -= dl; P1[r] -= dl; negm[r] = -m_run; } \
            if (HAS_OTHER) { _Pragma("unroll") for (int r = 0; r < 16; ++r) { Q0[r] -= dl; Q1[r] -= dl; } } \
            asm volatile("" : "+v"(negm)); \
            if (!first) { const float f = __builtin_amdgcn_exp2f(-dl); l_run *= f; \
                if (hi == 0) wsf[r32] = f; \
                LDS_WAIT(); \
                _Pragma("unroll") for (int g = 0; g < 4; ++g) { const f32x4 fv = *(const LAS f32x4*)(wsf + 8 * g + 4 * hi); \
                    _Pragma("unroll") for (int j = 0; j < 4; ++j) { o[0][4 * g + j] *= fv[j]; o[1][4 * g + j] *= fv[j]; } } } \
            first = false; } \
        float sacc = 0.f; \
        _Pragma("unroll") for (int r = 0; r < 16; ++r) { P0[r] = __builtin_amdgcn_exp2f(P0[r]); P1[r] = __builtin_amdgcn_exp2f(P1[r]); sacc += P0[r] + P1[r]; } \
        l_run += sacc; \
        _Pragma("unroll") for (int ks = 0; ks < 4; ++ks) { u32x4 w; \
            _Pragma("unroll") for (int jj = 0; jj < 4; ++jj) { const int r = 8 * (ks & 1) + 2 * jj; w[jj] = (ks < 2) ? pk2(P0[r], P0[r + 1]) : pk2(P1[r], P1[r + 1]); } \
            PA[ks] = __builtin_bit_cast(bf16x8, w); } } while (0)
#define A2_P(PA, vbase) do { const LAS unsigned char* vbp = lds + (vbase) + vlane; \
        _Pragma("unroll") for (int dh = 0; dh < 2; ++dh) \
            _Pragma("unroll") for (int ks = 0; ks < 4; ++ks) { \
                const s16x4 lo = vtr(vbp + dh * 4096 + ks * 1024), hi4 = vtr(vbp + dh * 4096 + ks * 1024 + 512); \
                const bf16x8 vf = (bf16x8){lo[0], lo[1], lo[2], lo[3], hi4[0], hi4[1], hi4[2], hi4[3]}; \
                o[dh] = __builtin_amdgcn_mfma_f32_32x32x16_bf16(PA[ks], vf, o[dh], 0, 0, 0); } } while (0)
    const int NT = J.kt_hi - J.kt_lo;
    VM_WAIT(); __syncthreads();
    for (int i = 0; i < NT; i += 2) {
        const int t = J.kt_lo + i, set = (i >> 1) & 1, sb = set * SETB;
        if (i + 2 < NT) { A2_STAGE(t + 2, set ^ 1, 0); A2_STAGE(t + 3, set ^ 1, 1); }
        A2_Q(pA0, pA1, sb); A2_Q(pB0, pB1, sb + KBYTES);
        A2_S(pA0, pA1, paA, pB0, pB1, true);
        A2_P(paA, sb + 2 * KBYTES);
        A2_S(pB0, pB1, paB, pB0, pB1, false);
        A2_P(paB, sb + 2 * KBYTES + 8192);
        VM_WAIT(); __syncthreads();
    }
    { auto rr = __builtin_amdgcn_permlane32_swap(__float_as_uint(l_run), __float_as_uint(l_run), false, false); l_run = __uint_as_float(rr[0]) + __uint_as_float(rr[1]); }
    if (hi == 0) wsf[32 + r32] = l_run;
    LDS_WAIT();
    LAS bf16_t* stg = (LAS bf16_t*)(lds + AT2_OST) + wid * 2048;
#pragma unroll
    for (int g = 0; g < 4; ++g) { const f32x4 lv = *(const LAS f32x4*)(wsf + 32 + 8 * g + 4 * hi);
#pragma unroll
        for (int j = 0; j < 4; ++j) { const int r = 4 * g + j; const float rl = 1.0f / lv[j]; const int orow = crow(r, hi);
            stg[orow * 64 + r32] = (bf16_t)(pk2(o[0][r] * rl, 0.f) & 0xffffu); stg[orow * 64 + 32 + r32] = (bf16_t)(pk2(o[1][r] * rl, 0.f) & 0xffffu); } }
    LDS_WAIT();
    bf16_t* Ow = J.O + (size_t)(wid * 32) * J.os;
#pragma unroll
    for (int q = 0; q < 4; ++q) { const int row = q * 8 + (lane >> 3), ch = lane & 7; const u32x4 v = *(const LAS u32x4*)(stg + row * 64 + ch * 8); *(u32x4*)(Ow + (size_t)row * J.os + ch * 8) = v; }
    LDS_WAIT(); __syncthreads();
#undef A2_STAGE
#undef A2_Q
#undef A2_S
#undef A2_P
}

#define APSBAR() __builtin_amdgcn_sched_barrier(0)
#define APPIN(x) asm volatile("" : "+v"(x))
template <int DQC>
__device__ __forceinline__ void attn_unit_pipe(const AttnJob& J, LAS unsigned char* lds) {
    const int tid = threadIdx.x, lane = tid & 63, r32 = lane & 31, hi = lane >> 5; const int wid = __builtin_amdgcn_readfirstlane(tid >> 6);
    constexpr int KBYTES = DQC * 2 * 1024, VOFF = 2 * KBYTES, NG = 2 * DQC;
    static_assert(VOFF + 16384 <= ATT_WSF, "attention LDS map");
    constexpr float THR = 8.0f;
    LAS float* wsf = (LAS float*)(lds + ATT_WSF) + wid * 64;
    const bf16_t* ksrcA = J.tiled ? J.K0 + wid * 512 + lane * 8 : J.K0 + (size_t)lane * J.k0s + wid * 8;
    const bf16_t* ksrcB = (DQC > 4) ? (J.tiled ? J.K1 + wid * 512 + lane * 8 : J.K1 + (size_t)lane * J.k1s + wid * 8) : ksrcA;
    const bf16_t* vsrc = J.tiled ? J.V + wid * 512 + lane * 8 : J.V + (size_t)(16 * (wid & 3) + (lane >> 2)) * J.vs + (wid >> 2) * 32 + (lane & 3) * 8;
    const size_t kAstep = J.tiled ? (size_t)J.k0s : (size_t)64 * J.k0s, kBstep = J.tiled ? (size_t)J.k1s : (size_t)64 * J.k1s, vstep = J.tiled ? (size_t)J.vs : (size_t)64 * J.vs;
#define AP_STAGE_K(t, kb) do { \
        glds16(ksrcA + (size_t)(t) * kAstep, (unsigned)__builtin_amdgcn_readfirstlane((unsigned)(uintptr_t)(lds + (kb) * KBYTES + wid * 1024))); \
        if (DQC > 4 && wid < 2 * DQC - 8) glds16(ksrcB + (size_t)(t) * kBstep, (unsigned)__builtin_amdgcn_readfirstlane((unsigned)(uintptr_t)(lds + (kb) * KBYTES + (8 + wid) * 1024))); } while (0)
#define AP_STAGE_V(t, vb) glds16(vsrc + (size_t)(t) * vstep, (unsigned)__builtin_amdgcn_readfirstlane((unsigned)(uintptr_t)(lds + VOFF + (vb) * 8192 + wid * 1024)))
#define AP_WAITBAR() do { asm volatile("s_waitcnt vmcnt(0) lgkmcnt(0)" ::: "memory"); __builtin_amdgcn_s_barrier(); asm volatile("" ::: "memory"); } while (0)
    const int NT = J.kt_hi - J.kt_lo, t0 = J.kt_lo;
    AP_STAGE_K(t0, 0);
    bf16x8 qr[DQC];
    { const bf16_t* qp = J.Q + (size_t)(wid * 32 + r32) * J.qs + hi * 8;
#pragma unroll
      for (int d0 = 0; d0 < DQC; ++d0) qr[d0] = *(const bf16x8*)(qp + d0 * 16); }
    float mhat = 0.f, l_reg = 0.f; f32x16 o[2], negm, pA0, pA1, pB0, pB1; bool resc = false;
#pragma unroll
    for (int r = 0; r < 16; ++r) { o[0][r] = 0.f; o[1][r] = 0.f; negm[r] = 0.f; }
    APPIN(negm);
    const LAS unsigned char* kp0 = lds + hi * 1024 + r32 * 16;
    const LAS unsigned char* vp0 = lds + VOFF + ((lane >> 4) & 1) * 32 + (lane & 3) * 8 + (4 * hi + ((lane & 15) >> 2)) * 64;
    bf16x8 kf[NG]; s16x4 vlo[8], vhi[8]; u32x4 pw0, pw1, pw2, pw3;
#define AP_KRD(g, kb) kf[g] = *(const LAS bf16x8*)(kp0 + (kb) * KBYTES + ((g) >> 1) * 2048 + ((g) & 1) * 512)
#define AP_VRD(i, vb) do { vlo[i] = vtr(vp0 + (vb) * 8192 + ((i) >> 2) * 4096 + ((i) & 3) * 1024); vhi[i] = vtr(vp0 + (vb) * 8192 + ((i) >> 2) * 4096 + ((i) & 3) * 1024 + 512); } while (0)
#define AP_VFR(i) (bf16x8){vlo[i][0], vlo[i][1], vlo[i][2], vlo[i][3], vhi[i][0], vhi[i][1], vhi[i][2], vhi[i][3]}
#define AP_PAF(k) __builtin_bit_cast(bf16x8, pw##k)
#define AP_MF(a, b, c) __builtin_amdgcn_mfma_f32_32x32x16_bf16(a, b, c, 0, 0, 0)
#define AP_EX(v) __builtin_amdgcn_exp2f(v)
#define AP_RESC() do { if (resc) { LDS_WAIT(); _Pragma("unroll") for (int g_ = 0; g_ < 4; ++g_) { const f32x4 fv = *(const LAS f32x4*)(wsf + 8 * g_ + 4 * hi); \
        _Pragma("unroll") for (int j_ = 0; j_ < 4; ++j_) { o[0][4 * g_ + j_] *= fv[j_]; o[1][4 * g_ + j_] *= fv[j_]; } } } } while (0)
#define AP_ROWMAX(C0, C1, rm) do { float a_ = max3f(C0[0], C0[1], C1[0]), c_ = max3f(C0[2], C0[3], C1[1]); a_ = max3f(a_, C1[2], C1[3]); \
        _Pragma("unroll") for (int r = 4; r < 16; r += 4) { a_ = max3f(a_, C0[r], C0[r + 1]); c_ = max3f(c_, C0[r + 2], C0[r + 3]); a_ = max3f(a_, C1[r], C1[r + 1]); c_ = max3f(c_, C1[r + 2], C1[r + 3]); } \
        rm = __builtin_fmaxf(a_, c_); auto rr_ = __builtin_amdgcn_permlane32_swap(__float_as_uint(rm), __float_as_uint(rm), false, false); \
        rm = __builtin_fmaxf(__uint_as_float(rr_[0]), __uint_as_float(rr_[1])); } while (0)
    AP_WAITBAR();
    AP_STAGE_K(t0 + 1, 1); AP_STAGE_V(t0, 0);
#pragma unroll
    for (int g = 0; g < NG; ++g) AP_KRD(g, 0);
    pA0 = AP_MF(kf[0], qr[0], negm); pA1 = AP_MF(kf[1], qr[0], negm);
#pragma unroll
    for (int d0 = 1; d0 < DQC; ++d0) { pA0 = AP_MF(kf[2 * d0], qr[d0], pA0); pA1 = AP_MF(kf[2 * d0 + 1], qr[d0], pA1); }
    { float rm; AP_ROWMAX(pA0, pA1, rm); mhat = rm;
#pragma unroll
      for (int r = 0; r < 16; ++r) { pA0[r] = AP_EX(pA0[r] - rm); pA1[r] = AP_EX(pA1[r] - rm); negm[r] = -mhat; }
      APPIN(negm); }
    AP_WAITBAR();
#define AP_GAPA(MFX, A0, A1, A2, W0, PW) do { MFX; sacc += A0; sacc += A1; sacc += A2; APPIN(sacc); W0; APPIN(PW); APSBAR(); } while (0)
#define AP_GAPA2(MFX, A0, A1, W0, W1, PW) do { MFX; sacc += A0; sacc += A1; APPIN(sacc); W0; W1; APPIN(PW); APSBAR(); } while (0)
#define AP_GAPB(MFX, X, B) do { MFX; X[B] = AP_EX(X[B]); X[B + 1] = AP_EX(X[B + 1]); X[B + 2] = AP_EX(X[B + 2]); X[B + 3] = AP_EX(X[B + 3]); APPIN(X); APSBAR(); } while (0)
#define AP_PKW(P, B) pk2(P[B], P[B + 1])
#define AP_STEP(C0, C1, P0, P1, i, HASK) do { APSBAR(); \
        const int kb_ = (i) & 1, vb_ = ((i) - 1) & 1; \
        if (HASK) AP_STAGE_K(t0 + (i) + 1, ((i) + 1) & 1); AP_STAGE_V(t0 + (i), (i) & 1); \
        AP_KRD(0, kb_); AP_KRD(1, kb_); AP_KRD(2, kb_); AP_KRD(3, kb_); APSBAR(); \
        float sacc = 0.f; \
        if (DQC == 6) { \
        AP_VRD(0, vb_); AP_KRD(4, kb_);  APSBAR(); AP_GAPA(C0 = AP_MF(kf[0], qr[0], negm), P0[0], P0[1], P0[2],    pw0[0] = AP_PKW(P0, 0),  pw0); \
        AP_VRD(4, vb_); AP_KRD(5, kb_);  APSBAR(); AP_GAPA(C1 = AP_MF(kf[1], qr[0], negm), P0[3], P0[4], P0[5],    pw0[1] = AP_PKW(P0, 2),  pw0); \
        AP_VRD(1, vb_); AP_KRD(6, kb_);  APSBAR(); AP_GAPA(C0 = AP_MF(kf[2], qr[1], C0),   P0[6], P0[7], P0[8],    pw0[2] = AP_PKW(P0, 4),  pw0); \
        AP_VRD(5, vb_); AP_KRD(7, kb_);  APSBAR(); AP_GAPA(C1 = AP_MF(kf[3], qr[1], C1),   P0[9], P0[10], P0[11],  pw0[3] = AP_PKW(P0, 6),  pw0); \
        AP_VRD(2, vb_); AP_KRD(8, kb_);  APSBAR(); AP_GAPA(C0 = AP_MF(kf[4], qr[2], C0),   P0[12], P0[13], P0[14], pw1[0] = AP_PKW(P0, 8),  pw1); \
        AP_VRD(6, vb_); AP_KRD(9, kb_);  APSBAR(); AP_GAPA(C1 = AP_MF(kf[5], qr[2], C1),   P0[15], P1[0], P1[1],   pw1[1] = AP_PKW(P0, 10), pw1); \
        AP_VRD(3, vb_); AP_KRD(10, kb_); APSBAR(); AP_GAPA(C0 = AP_MF(kf[6], qr[3], C0),   P1[2], P1[3], P1[4],    pw1[2] = AP_PKW(P0, 12), pw1); \
        AP_VRD(7, vb_); AP_KRD(11, kb_); APSBAR(); AP_GAPA(C1 = AP_MF(kf[7], qr[3], C1),   P1[5], P1[6], P1[7],    pw1[3] = AP_PKW(P0, 14), pw1); \
        AP_GAPA2(C0 = AP_MF(kf[8], qr[4], C0),  P1[8], P1[9],   pw2[0] = AP_PKW(P1, 0), pw2[1] = AP_PKW(P1, 2),   pw2); \
        AP_GAPA2(C1 = AP_MF(kf[9], qr[4], C1),  P1[10], P1[11], pw2[2] = AP_PKW(P1, 4), pw2[3] = AP_PKW(P1, 6),   pw2); \
        AP_GAPA2(C0 = AP_MF(kf[10], qr[5], C0), P1[12], P1[13], pw3[0] = AP_PKW(P1, 8), pw3[1] = AP_PKW(P1, 10),  pw3); \
        AP_GAPA2(C1 = AP_MF(kf[11], qr[5], C1), P1[14], P1[15], pw3[2] = AP_PKW(P1, 12), pw3[3] = AP_PKW(P1, 14), pw3); \
        } else { \
        AP_VRD(0, vb_); AP_KRD(4, kb_); APSBAR(); AP_GAPA2(C0 = AP_MF(kf[0], qr[0], negm), P0[0], P0[1],   pw0[0] = AP_PKW(P0, 0), pw0[1] = AP_PKW(P0, 2),   pw0); sacc += P0[2]; sacc += P0[3]; \
        AP_VRD(4, vb_); AP_KRD(5, kb_); APSBAR(); AP_GAPA2(C1 = AP_MF(kf[1], qr[0], negm), P0[4], P0[5],   pw0[2] = AP_PKW(P0, 4), pw0[3] = AP_PKW(P0, 6),   pw0); sacc += P0[6]; sacc += P0[7]; \
        AP_VRD(1, vb_); AP_KRD(6, kb_); APSBAR(); AP_GAPA2(C0 = AP_MF(kf[2], qr[1], C0),   P0[8], P0[9],   pw1[0] = AP_PKW(P0, 8), pw1[1] = AP_PKW(P0, 10),  pw1); sacc += P0[10]; sacc += P0[11]; \
        AP_VRD(5, vb_); AP_KRD(7, kb_); APSBAR(); AP_GAPA2(C1 = AP_MF(kf[3], qr[1], C1),   P0[12], P0[13], pw1[2] = AP_PKW(P0, 12), pw1[3] = AP_PKW(P0, 14), pw1); sacc += P0[14]; sacc += P0[15]; \
        AP_VRD(2, vb_); APSBAR(); AP_GAPA2(C0 = AP_MF(kf[4], qr[2], C0),   P1[0], P1[1],   pw2[0] = AP_PKW(P1, 0), pw2[1] = AP_PKW(P1, 2),   pw2); sacc += P1[2]; sacc += P1[3]; \
        AP_VRD(6, vb_); APSBAR(); AP_GAPA2(C1 = AP_MF(kf[5], qr[2], C1),   P1[4], P1[5],   pw2[2] = AP_PKW(P1, 4), pw2[3] = AP_PKW(P1, 6),   pw2); sacc += P1[6]; sacc += P1[7]; \
        AP_VRD(3, vb_); APSBAR(); AP_GAPA2(C0 = AP_MF(kf[6], qr[3], C0),   P1[8], P1[9],   pw3[0] = AP_PKW(P1, 8), pw3[1] = AP_PKW(P1, 10),  pw3); sacc += P1[10]; sacc += P1[11]; \
        AP_VRD(7, vb_); APSBAR(); AP_GAPA2(C1 = AP_MF(kf[7], qr[3], C1),   P1[12], P1[13], pw3[2] = AP_PKW(P1, 12), pw3[3] = AP_PKW(P1, 14), pw3); sacc += P1[14]; sacc += P1[15]; \
        } \
        l_reg += sacc; \
        { float rm; AP_ROWMAX(C0, C1, rm); resc = false; \
          if (__builtin_expect(__any(rm > THR), 0)) { const float dl = __builtin_fmaxf(rm, 0.f); mhat += dl; \
              _Pragma("unroll") for (int r = 0; r < 16; ++r) { C0[r] -= dl; C1[r] -= dl; negm[r] = -mhat; } APPIN(negm); \
              const float f = AP_EX(-dl); l_reg *= f; if (hi == 0) wsf[r32] = f; resc = true; } } \
        APSBAR(); \
        AP_GAPB(o[0] = AP_MF(AP_PAF(0), AP_VFR(0), o[0]), C0, 0);  AP_GAPB(o[1] = AP_MF(AP_PAF(0), AP_VFR(4), o[1]), C0, 4); \
        AP_GAPB(o[0] = AP_MF(AP_PAF(1), AP_VFR(1), o[0]), C0, 8);  AP_GAPB(o[1] = AP_MF(AP_PAF(1), AP_VFR(5), o[1]), C0, 12); \
        AP_GAPB(o[0] = AP_MF(AP_PAF(2), AP_VFR(2), o[0]), C1, 0);  AP_GAPB(o[1] = AP_MF(AP_PAF(2), AP_VFR(6), o[1]), C1, 4); \
        AP_GAPB(o[0] = AP_MF(AP_PAF(3), AP_VFR(3), o[0]), C1, 8);  AP_GAPB(o[1] = AP_MF(AP_PAF(3), AP_VFR(7), o[1]), C1, 12); \
    } while (0)
    int i = 1;
    for (; i + 2 < NT; i += 2) {
        AP_STEP(pB0, pB1, pA0, pA1, i, true);     AP_WAITBAR(); AP_RESC();
        AP_STEP(pA0, pA1, pB0, pB1, i + 1, true); AP_WAITBAR(); AP_RESC();
    }
    if (i + 1 < NT) {
        AP_STEP(pB0, pB1, pA0, pA1, i, true);      AP_WAITBAR(); AP_RESC();
        AP_STEP(pA0, pA1, pB0, pB1, i + 1, false); AP_WAITBAR(); AP_RESC();
    } else {
        AP_STEP(pB0, pB1, pA0, pA1, i, false);     AP_WAITBAR(); AP_RESC();
#pragma unroll
        for (int r = 0; r < 16; ++r) { pA0[r] = pB0[r]; pA1[r] = pB1[r]; }
    }
    { float sacc = 0.f;
#pragma unroll
      for (int r = 0; r < 16; ++r) sacc += pA0[r];
#pragma unroll
      for (int r = 0; r < 16; ++r) sacc += pA1[r];
      l_reg += sacc;
      pw0 = (u32x4){AP_PKW(pA0, 0), AP_PKW(pA0, 2), AP_PKW(pA0, 4), AP_PKW(pA0, 6)}; pw1 = (u32x4){AP_PKW(pA0, 8), AP_PKW(pA0, 10), AP_PKW(pA0, 12), AP_PKW(pA0, 14)};
      pw2 = (u32x4){AP_PKW(pA1, 0), AP_PKW(pA1, 2), AP_PKW(pA1, 4), AP_PKW(pA1, 6)}; pw3 = (u32x4){AP_PKW(pA1, 8), AP_PKW(pA1, 10), AP_PKW(pA1, 12), AP_PKW(pA1, 14)};
      const int vb_ = (NT - 1) & 1;
#pragma unroll
      for (int q = 0; q < 8; ++q) AP_VRD(q, vb_);
      o[0] = AP_MF(AP_PAF(0), AP_VFR(0), o[0]); o[1] = AP_MF(AP_PAF(0), AP_VFR(4), o[1]); o[0] = AP_MF(AP_PAF(1), AP_VFR(1), o[0]); o[1] = AP_MF(AP_PAF(1), AP_VFR(5), o[1]);
      o[0] = AP_MF(AP_PAF(2), AP_VFR(2), o[0]); o[1] = AP_MF(AP_PAF(2), AP_VFR(6), o[1]); o[0] = AP_MF(AP_PAF(3), AP_VFR(3), o[0]); o[1] = AP_MF(AP_PAF(3), AP_VFR(7), o[1]); }
    { auto rr = __builtin_amdgcn_permlane32_swap(__float_as_uint(l_reg), __float_as_uint(l_reg), false, false); l_reg = __uint_as_float(rr[0]) + __uint_as_float(rr[1]); }
    if (hi == 0) wsf[32 + r32] = l_reg;
    LDS_WAIT();
    LAS bf16_t* stg = (LAS bf16_t*)(lds + ATT_OST) + wid * 2048;
#pragma unroll
    for (int g = 0; g < 4; ++g) { const f32x4 lv = *(const LAS f32x4*)(wsf + 32 + 8 * g + 4 * hi);
#pragma unroll
        for (int j = 0; j < 4; ++j) { const int r = 4 * g + j; const float rl = 1.0f / lv[j]; const int orow = crow(r, hi);
            stg[orow * 64 + r32] = (bf16_t)(pk2(o[0][r] * rl, 0.f) & 0xffffu); stg[orow * 64 + 32 + r32] = (bf16_t)(pk2(o[1][r] * rl, 0.f) & 0xffffu); } }
    LDS_WAIT();
    bf16_t* Ow = J.O + (size_t)(wid * 32) * J.os;
#pragma unroll
    for (int q = 0; q < 4; ++q) { const int row = q * 8 + (lane >> 3), ch = lane & 7; const u32x4 v = *(const LAS u32x4*)(stg + row * 64 + ch * 8); *(u32x4*)(Ow + (size_t)row * J.os + ch * 8) = v; }
    asm volatile("s_waitcnt lgkmcnt(0)" ::: "memory"); __builtin_amdgcn_s_barrier(); asm volatile("" ::: "memory");
#undef AP_STAGE_K
#undef AP_STAGE_V
#undef AP_WAITBAR
#undef AP_KRD
#undef AP_VRD
#undef AP_VFR
#undef AP_PAF
#undef AP_MF
#undef AP_EX
#undef AP_RESC
#undef AP_ROWMAX
#undef AP_GAPA
#undef AP_GAPA2
#undef AP_GAPB
#undef AP_PKW
#undef AP_STEP
}

constexpr int MISC_HIST = MISC_OFF + 256, MISC_TSTART = MISC_OFF + 512, MISC_TOT = MISC_OFF + 768, MISC_PRE = MISC_OFF + 896, MISC_PSTART = MISC_OFF + 1024, MISC_RANK = MISC_OFF + 1152;

__device__ __forceinline__ void tr_item(const float* W, int ldw, int k0, int n0, bf16_t* WT, int ldt, int orow0, int kout0, const float* kscale, LAS float* scr, int lane) {
#pragma unroll 8
    for (int kk = 0; kk < 64; ++kk) { float v = W[(size_t)(k0 + kk) * ldw + n0 + lane]; if (kscale) v *= kscale[k0 + kk]; scr[kk * 64 + (lane ^ (kk & 31))] = v; }
    LDS_WAIT();
    const int c = lane >> 3;
#pragma unroll
    for (int j = 0; j < 8; ++j) { const int n = (lane & 7) + 8 * j; float f[8];
#pragma unroll
        for (int i = 0; i < 8; ++i) { const int kk = 8 * c + i; f[i] = scr[kk * 64 + (n ^ (kk & 31))]; }
        u32x4 o; o.x = pk2(f[0], f[1]); o.y = pk2(f[2], f[3]); o.z = pk2(f[4], f[5]); o.w = pk2(f[6], f[7]);
        *(u32x4*)(WT + (size_t)(orow0 + n) * ldt + kout0 + k0 + 8 * c) = o; }
    LDS_WAIT();
}
__device__ __forceinline__ void tr_item_g(const float* W, int ncols, int k0, int n0, bf16_t* WT, int ldt, int orow0, LAS float* scr, int lane) {
#pragma unroll 8
    for (int kk = 0; kk < 64; ++kk) { const float v = (n0 + lane < ncols) ? W[(size_t)(k0 + kk) * ncols + n0 + lane] : 0.f; scr[kk * 64 + (lane ^ (kk & 31))] = v; }
    LDS_WAIT();
    const int c = lane >> 3;
#pragma unroll
    for (int j = 0; j < 8; ++j) { const int n = (lane & 7) + 8 * j; float f[8];
#pragma unroll
        for (int i = 0; i < 8; ++i) { const int kk = 8 * c + i; f[i] = scr[kk * 64 + (n ^ (kk & 31))]; }
        u32x4 o; o.x = pk2(f[0], f[1]); o.y = pk2(f[2], f[3]); o.z = pk2(f[4], f[5]); o.w = pk2(f[6], f[7]);
        *(u32x4*)(WT + (size_t)(orow0 + n) * ldt + k0 + 8 * c) = o; }
    LDS_WAIT();
}
struct ProIn { const float *x, *mem, *a_w_in, *a_w_out, *b_w_in, *b_q_norm, *b_w_qb, *b_kv_norm, *b_w_kvb, *b_w_out, *mem_w_kv, *w_grp, *w_exp, *w_gate, *w_up, *w_down; };
__device__ __forceinline__ void prologue_phase(const ProIn& I, unsigned char* ws, LAS unsigned char* lds, int gw, int NGW, int lane) {
    LAS float* scr = (LAS float*)(lds + (threadIdx.x >> 6) * 16384);
    constexpr int I0 = 16 * 40, I1 = 8 * 16, I2 = 16 * 12, I3 = 4 * 12, I4 = 2 * 16, I5 = 12 * 16, I6 = 16 * 8, I7 = 16 * 8;
    constexpr int NSMALL = I0 + I1 + I2 + I3 + I4 + I5 + I6 + I7, NEXPI = 64 * 384;
    for (int it = gw; it < NSMALL + NEXPI; it += NGW) {
        int r = it;
        if (r < NSMALL) {
            const float* W; int K, N; size_t wt; int ldt, kout0 = 0, orow = 0; const float* ks = nullptr;
            if (r < I0) { W = I.a_w_in; K = 1024; N = 2560; wt = WS_WINA; ldt = 1024; }
            else if ((r -= I0) < I1) { W = I.a_w_out; K = 512; N = 1024; wt = WS_WOUTA; ldt = 512; }
            else if ((r -= I1) < I2) { W = I.b_w_in; K = 1024; N = 768; wt = WS_WINB; ldt = 1024; }
            else if ((r -= I2) < I3) { W = I.b_w_qb; K = 256; N = 768; wt = WS_WQB; ldt = 256; ks = I.b_q_norm; }
            else if ((r -= I3) < I4) { W = I.b_w_kvb; K = 128; N = 1024; wt = WS_WKVB; ldt = 256; kout0 = 128; ks = I.b_kv_norm; }
            else if ((r -= I4) < I5) { W = I.b_w_out; K = 768; N = 1024; wt = WS_WOUTB; ldt = 768; }
            else if ((r -= I5) < I6) { W = I.mem_w_kv; K = 1024; N = 512; wt = WS_WMEM; ldt = 1024; }
            else { r -= I6; W = I.mem_w_kv + (size_t)1024 * 512; K = 1024; N = 512; wt = WS_WMEM; ldt = 1024; orow = 512; }
            const int nblk = N / 64, kb = r / nblk, nb = r % nblk;
            if (W == I.b_w_in) tr_item_g(W, 672, kb * 64, nb * 64, (bf16_t*)(ws + wt), ldt, orow + nb * 64, scr, lane);
            else tr_item(W, N, kb * 64, nb * 64, (bf16_t*)(ws + wt), ldt, orow + nb * 64, kout0, ks, scr, lane);
        } else {
            r -= NSMALL; const int le = r / 384, q = r % 384, which = q / 128, s = q % 128;
            if (which < 2) {
                const float* W = (which == 0 ? I.w_gate : I.w_up) + (size_t)le * 1024 * 512; const int kb = s / 8, nb = s % 8, n0 = nb * 64;
                tr_item(W, 512, kb * 64, n0, (bf16_t*)(ws + WS_WGU) + (size_t)le * 1024 * 1024, 1024, 256 * (n0 >> 7) + 128 * which + (n0 & 127), 0, nullptr, scr, lane);
            } else {
                const float* W = I.w_down + (size_t)le * 512 * 1024; const int kb = s / 16, nb = s % 16;
                tr_item(W, 1024, kb * 64, nb * 64, (bf16_t*)(ws + WS_WD) + (size_t)le * 1024 * 512, 512, nb * 64, 0, nullptr, scr, lane);
            }
        }
    }
    const size_t gt = (size_t)gw * 64 + lane, NGT = (size_t)NGW * 64;
    { u32x4 z = {0u, 0u, 0u, 0u};
      for (size_t i = gt; i < (size_t)96 * 1024 / 8; i += NGT) *(u32x4*)((bf16_t*)(ws + WS_WINB) + (size_t)672 * 1024 + i * 8) = z;
      for (size_t i = gt; i < (size_t)1024 * 16; i += NGT) *(u32x4*)((bf16_t*)(ws + WS_WKVB) + (i >> 4) * 256 + (i & 15) * 8) = z;
      for (size_t i = gt; i < (size_t)2 * 12 * 128; i += NGT) { const size_t l = i / (12 * 128), rem = i % (12 * 128); *(u32x4*)((bf16_t*)(ws + WS_WR) + (l * 48 + 36) * 1024 + rem * 8) = z; } }
    for (size_t i = gt; i < (size_t)2 * 36 * 1024; i += NGT) { const int l = (int)(i / (36 * 1024)), rem = (int)(i % (36 * 1024)), row = rem / 1024, k = rem % 1024;
        const float v = row < 4 ? I.w_grp[((size_t)l * 1024 + k) * 4 + row] : I.w_exp[((size_t)l * 1024 + k) * 32 + (row - 4)];
        ((bf16_t*)(ws + WS_WR))[((size_t)l * 48 + row) * 1024 + k] = (bf16_t)(pk2(v, 0.f) & 0xffffu); }
    for (size_t i = gt; i < (size_t)NTOK * DM / 8; i += NGT) { const f32x4 a = ((const f32x4*)I.x)[2 * i], b = ((const f32x4*)I.x)[2 * i + 1];
        u32x4 o; o.x = pk2(a[0], a[1]); o.y = pk2(a[2], a[3]); o.z = pk2(b[0], b[1]); o.w = pk2(b[2], b[3]); ((u32x4*)(ws + WS_X))[i] = o; }
    for (size_t i = gt; i < (size_t)NMEM * DM / 8; i += NGT) { const f32x4 a = ((const f32x4*)I.mem)[2 * i], b = ((const f32x4*)I.mem)[2 * i + 1];
        u32x4 o; o.x = pk2(a[0], a[1]); o.y = pk2(a[2], a[3]); o.z = pk2(b[0], b[1]); o.w = pk2(b[2], b[3]); ((u32x4*)(ws + WS_MEMB))[i] = o; }
    for (size_t i = gt; i < (size_t)SEQ * 8; i += NGT) { const int pos = (int)(i >> 3), k = (int)(i & 7); const float inv = powf(500000.0f, -((float)(2 * k) / 16.0f)); const float ang = (float)pos * inv;
        ((f32x2*)(ws + WS_ROPEA))[i] = (f32x2){cosf(ang), sinf(ang)}; }
    for (size_t i = gt; i < (size_t)SEQ * 16; i += NGT) { const int pos = (int)(i >> 4), k = (int)(i & 15); const float inv = powf(500000.0f, -((float)(2 * k) / 32.0f)); const float ang = (float)pos * inv;
        ((f32x2*)(ws + WS_ROPEB))[i] = (f32x2){cosf(ang), sinf(ang)}; }
}

__device__ __forceinline__ void merge_phase(unsigned char* ws, int gw, int NGW, int lane) {
    const bf16_t* OG = (const bf16_t*)(ws + WS_OG); const float* LSE = (const float*)(ws + WS_LSE); bf16_t* CAT = (bf16_t*)(ws + WS_CAT);
    for (int tok = gw; tok < NTOK; tok += NGW) {
        const int j = lane >> 4;
        float l0 = LSE[(size_t)tok * 4 + j], l1 = LSE[(size_t)NTOK * 4 + (size_t)tok * 4 + j], l2 = LSE[(size_t)2 * NTOK * 4 + (size_t)tok * 4 + j];
        const float mx = max3f(l0, l1, l2); l0 = __builtin_amdgcn_exp2f(l0 - mx); l1 = __builtin_amdgcn_exp2f(l1 - mx); l2 = __builtin_amdgcn_exp2f(l2 - mx);
        const float inv = 1.0f / (l0 + l1 + l2);
        const u32x2 a = *(const u32x2*)(OG + (size_t)tok * 256 + lane * 4), b = *(const u32x2*)(OG + (size_t)NTOK * 256 + (size_t)tok * 256 + lane * 4), c = *(const u32x2*)(OG + (size_t)2 * NTOK * 256 + (size_t)tok * 256 + lane * 4);
        f32x4 v;
        v[0] = (l0 * bflo(a.x) + l1 * bflo(b.x) + l2 * bflo(c.x)) * inv; v[1] = (l0 * bfhi(a.x) + l1 * bfhi(b.x) + l2 * bfhi(c.x)) * inv;
        v[2] = (l0 * bflo(a.y) + l1 * bflo(b.y) + l2 * bflo(c.y)) * inv; v[3] = (l0 * bfhi(a.y) + l1 * bfhi(b.y) + l2 * bfhi(c.y)) * inv;
        st4(CAT + (size_t)tok * 512 + lane * 4, v);
    }
}

__device__ __forceinline__ void ln_core(float (&v)[16], const float (&g)[16], const float (&b)[16]) {
    float s = 0.f;
#pragma unroll
    for (int i = 0; i < 16; ++i) s += v[i];
    const float mean = wave_sum(s) * (1.f / DM); float q = 0.f;
#pragma unroll
    for (int i = 0; i < 16; ++i) { v[i] -= mean; q += v[i] * v[i]; }
    const float rstd = 1.0f / sqrtf(wave_sum(q) * (1.f / DM) + LN_EPS);
#pragma unroll
    for (int i = 0; i < 16; ++i) v[i] = v[i] * rstd * g[i] + b[i];
}
__device__ __forceinline__ void load_gb(const float* gp, const float* bp, int lane, float (&g)[16], float (&b)[16]) {
#pragma unroll
    for (int h = 0; h < 2; ++h)
#pragma unroll
        for (int q = 0; q < 2; ++q) { const f32x4 gv = *(const f32x4*)(gp + h * 512 + lane * 8 + q * 4), bv = *(const f32x4*)(bp + h * 512 + lane * 8 + q * 4);
#pragma unroll
            for (int j = 0; j < 4; ++j) { g[h * 8 + q * 4 + j] = gv[j]; b[h * 8 + q * 4 + j] = bv[j]; } }
}
__device__ __forceinline__ void unpack8(const u32x4 w, float* o) { o[0] = bflo(w.x); o[1] = bfhi(w.x); o[2] = bflo(w.y); o[3] = bfhi(w.y); o[4] = bflo(w.z); o[5] = bfhi(w.z); o[6] = bflo(w.w); o[7] = bfhi(w.w); }
__device__ __forceinline__ u32x4 pack8(const float* v) { u32x4 o; o.x = pk2(v[0], v[1]); o.y = pk2(v[2], v[3]); o.z = pk2(v[4], v[5]); o.w = pk2(v[6], v[7]); return o; }

__device__ __forceinline__ void ln_mix_phase(unsigned char* ws, const float* lng, const float* lnb, int gw, int NGW, int lane) {
    const bf16_t* X = (const bf16_t*)(ws + WS_X); bf16_t* XO = (bf16_t*)(ws + WS_XB); const bf16_t* Y = (const bf16_t*)(ws + WS_Y);
    float g[16], b[16]; load_gb(lng, lnb, lane, g, b);
    for (int row = gw; row < NTOK; row += NGW) {
        const size_t ro = (size_t)row * DM;
        const u32x4 xa = *(const u32x4*)(X + ro + lane * 8), xb = *(const u32x4*)(X + ro + 512 + lane * 8);
        const u32x4 ya = *(const u32x4*)(Y + ro + lane * 8), yb = *(const u32x4*)(Y + ro + 512 + lane * 8);
        float v[16], t[16]; unpack8(xa, v); unpack8(xb, v + 8); unpack8(ya, t); unpack8(yb, t + 8);
#pragma unroll
        for (int i = 0; i < 16; ++i) v[i] = ALPHA * v[i] + t[i];
        ln_core(v, g, b);
        *(u32x4*)(XO + ro + lane * 8) = pack8(v); *(u32x4*)(XO + ro + 512 + lane * 8) = pack8(v + 8);
    }
}
constexpr int RT_WROW = 2064, RT_SC = 102400;
__device__ __forceinline__ void router_phase(unsigned char* ws, const bf16_t* WR, const float* bgrp, const float* bexp, LAS unsigned char* lds, int vcu, int G, int wave, int lane) {
    const bf16_t* X = (const bf16_t*)(ws + WS_XB);
    int* tok_eid = (int*)(ws + WS_TOKEID); float* tok_gw = (float*)(ws + WS_TOKGW); unsigned* wgcnt = (unsigned*)(ws + WS_WGCNT);
    for (int idx = threadIdx.x; idx < 48 * 128; idx += NTHREADS) { const int row = idx >> 7, ch = idx & 127; *(LAS u32x4*)(lds + row * RT_WROW + ch * 16) = *(const u32x4*)(WR + (size_t)row * 1024 + ch * 8); }
    LAS int* hist = (LAS int*)(lds + MISC_HIST);
    if (threadIdx.x < 32) hist[threadIdx.x] = 0;
    __syncthreads();
    LAS float* sc = (LAS float*)(lds + RT_SC) + wave * 768;
    for (int task = vcu * NWAVES + wave; task < NTOK / 16; task += G * NWAVES) {
        const int row0 = task * 16;
        f32x4 acc[3];
#pragma unroll
        for (int n = 0; n < 3; ++n) acc[n] = (f32x4){0.f, 0.f, 0.f, 0.f};
        const bf16_t* ap = X + (size_t)(row0 + (lane & 15)) * DM + 8 * (lane >> 4);
        const LAS unsigned char* wb = lds + (lane & 15) * RT_WROW + (lane >> 4) * 16;
#pragma unroll 8
        for (int kk = 0; kk < 32; ++kk) { const bf16x8 a = *(const bf16x8*)(ap + kk * 32);
#pragma unroll
            for (int n = 0; n < 3; ++n) { const bf16x8 w = *(const LAS bf16x8*)(wb + n * 16 * RT_WROW + kk * 64); acc[n] = __builtin_amdgcn_mfma_f32_16x16x32_bf16(a, w, acc[n], 0, 0, 0); } }
#pragma unroll
        for (int n = 0; n < 3; ++n)
#pragma unroll
            for (int r = 0; r < 4; ++r) sc[((lane >> 4) * 4 + r) * 48 + n * 16 + (lane & 15)] = acc[n][r];
        LDS_WAIT();
        if (lane < 16) {
            const LAS float* lg = sc + lane * 48; const int tok = row0 + lane;
            const float g0 = lg[0] + bgrp[0], g1 = lg[1] + bgrp[1], g2 = lg[2] + bgrp[2], g3 = lg[3] + bgrp[3];
            int gi = 0; float gm = g0; if (g1 > gm) { gm = g1; gi = 1; } if (g2 > gm) { gm = g2; gi = 2; } if (g3 > gm) { gm = g3; gi = 3; }
            const float ggate = 1.0f / (__expf(g0 - gm) + __expf(g1 - gm) + __expf(g2 - gm) + __expf(g3 - gm));
            float b1 = -3.0e38f, b2 = -3.0e38f; int i1 = 0, i2 = 0;
#pragma unroll
            for (int k = 0; k < 8; ++k) { const float vv = lg[4 + gi * 8 + k] + bexp[gi * 8 + k];
                if (vv > b1) { b2 = b1; i2 = i1; b1 = vv; i1 = k; } else if (vv > b2) { b2 = vv; i2 = k; } }
            const float e2 = __expf(b2 - b1), p1 = 1.0f / (1.0f + e2), p2 = e2 * p1;
            const int e_1 = gi * 8 + i1, e_2 = gi * 8 + i2;
            *(int2*)(tok_eid + (size_t)tok * 2) = make_int2(e_1, e_2); *(float2*)(tok_gw + (size_t)tok * 2) = make_float2(p1 * ggate, p2 * ggate);
            atomicAdd((int*)(hist + e_1), 1); atomicAdd((int*)(hist + e_2), 1);
        }
        LDS_WAIT();
    }
    __syncthreads();
    if (threadIdx.x < 32) wgcnt[blockIdx.x * 32 + threadIdx.x] = (unsigned)hist[threadIdx.x];
}

__device__ __forceinline__ void assign_phase(unsigned char* ws, LAS unsigned char* lds, int vcu, int G, int wave, int lane) {
    const unsigned* wgcnt = (const unsigned*)(ws + WS_WGCNT); const int* tok_eid = (const int*)(ws + WS_TOKEID);
    int* tok_slot = (int*)(ws + WS_TOKSLOT); int* slot_tok = (int*)(ws + WS_SLOTTOK); int* meta = (int*)(ws + WS_META);
    LAS int* part = (LAS int*)lds;
    LAS int* tstart = (LAS int*)(lds + MISC_TSTART); LAS int* tot = (LAS int*)(lds + MISC_TOT); LAS int* pre = (LAS int*)(lds + MISC_PRE);
    LAS int* pstart = (LAS int*)(lds + MISC_PSTART); LAS int* rank = (LAS int*)(lds + MISC_RANK);
    const int tid = threadIdx.x, me = blockIdx.x;
    { const int e = tid & 31, p = tid >> 5; int t = 0, pr = 0;
      for (int w = p; w < G; w += 16) { const int v = (int)wgcnt[w * 32 + e]; t += v; if (w < me) pr += v; }
      part[(p * 32 + e) * 2] = t; part[(p * 32 + e) * 2 + 1] = pr; }
    __syncthreads();
    if (tid < 32) { int t = 0, pr = 0; for (int p = 0; p < 16; ++p) { t += part[(p * 32 + tid) * 2]; pr += part[(p * 32 + tid) * 2 + 1]; } tot[tid] = t; pre[tid] = pr; rank[tid] = 0; }
    __syncthreads();
    if (tid == 0) { int acc = 0; for (int e = 0; e < NEXP; ++e) { tstart[e] = acc; pstart[e] = acc * 256; acc += (tot[e] + 255) >> 8; } tstart[NEXP] = acc; }
    __syncthreads();
    if (me == 0 && tid <= NEXP) meta[tid] = tstart[tid];
    if (me == 0 && tid < NEXP) meta[64 + tid] = tot[tid];
    if (me < NEXP) { const int e = me, s0 = pstart[e] + tot[e], s1 = tstart[e + 1] * 256; for (int s = s0 + tid; s < s1; s += NTHREADS) slot_tok[s] = 0; }
    for (int task = vcu * NWAVES + wave; task < NTOK / 16; task += G * NWAVES) {
        if (lane < 32) { const int tok = task * 16 + (lane >> 1), k = lane & 1; const int e = tok_eid[(size_t)tok * 2 + k];
            const int rk = atomicAdd((int*)(rank + e), 1); const int slot = pstart[e] + pre[e] + rk;
            slot_tok[slot] = tok; tok_slot[(size_t)tok * 2 + k] = slot; }
    }
    __syncthreads();
}

template <bool FINAL>
__device__ __forceinline__ void ln_moe_phase(unsigned char* ws, const float* lng, const float* lnb, float* out, int gw, int NGW, int lane) {
    const bf16_t* XI = (const bf16_t*)(ws + WS_XB); bf16_t* X = (bf16_t*)(ws + WS_X); const bf16_t* YS = (const bf16_t*)(ws + WS_YS);
    const int* tok_slot = (const int*)(ws + WS_TOKSLOT); const float* tok_gw = (const float*)(ws + WS_TOKGW);
    float g[16], b[16]; load_gb(lng, lnb, lane, g, b);
    for (int tok = gw; tok < NTOK; tok += NGW) {
        const int2 sl = *(const int2*)(tok_slot + (size_t)tok * 2); const float2 gwt = *(const float2*)(tok_gw + (size_t)tok * 2);
        const size_t ro = (size_t)tok * DM;
        const u32x4 xa = *(const u32x4*)(XI + ro + lane * 8), xb = *(const u32x4*)(XI + ro + 512 + lane * 8);
        const u32x4 pa = *(const u32x4*)(YS + (size_t)sl.x * DM + lane * 8), pb = *(const u32x4*)(YS + (size_t)sl.x * DM + 512 + lane * 8);
        const u32x4 qa = *(const u32x4*)(YS + (size_t)sl.y * DM + lane * 8), qb = *(const u32x4*)(YS + (size_t)sl.y * DM + 512 + lane * 8);
        float v[16], t[16], u[16]; unpack8(xa, v); unpack8(xb, v + 8); unpack8(pa, t); unpack8(pb, t + 8); unpack8(qa, u); unpack8(qb, u + 8);
#pragma unroll
        for (int i = 0; i < 16; ++i) v[i] = ALPHA * v[i] + (gwt.x * t[i] + gwt.y * u[i]);
        ln_core(v, g, b);
        if (FINAL) {
#pragma unroll
            for (int h = 0; h < 2; ++h)
#pragma unroll
                for (int q = 0; q < 2; ++q) *(f32x4*)(out + ro + h * 512 + lane * 8 + q * 4) = (f32x4){v[h * 8 + q * 4], v[h * 8 + q * 4 + 1], v[h * 8 + q * 4 + 2], v[h * 8 + q * 4 + 3]};
        } else { *(u32x4*)(X + ro + lane * 8) = pack8(v); *(u32x4*)(X + ro + 512 + lane * 8) = pack8(v + 8); }
    }
}

__device__ __forceinline__ void mem_attn_units(const bf16_t* Qb, int qs, int qcol, const bf16_t* MK, int layer, bf16_t* Ob, int os, int ocol, LAS unsigned char* lds, int vcu, int G) {
    const int upw = (1024 + G - 1) / G;
    for (int i = 0; i < upw; ++i) { const int u = vcu * upw + i; if (u >= 1024) break;
        const int b = u >> 6, h = (u >> 4) & 3, qb = u & 15;
        AttnJob J; J.Q = Qb + (size_t)(b * SEQ + qb * 256) * qs + qcol + h * 64; J.qs = qs;
        J.K0 = MK + ((size_t)((layer * 16 + b) * 4 + h) * 4) * 8192; J.k0s = 8192; J.K1 = J.K0; J.k1s = 8192; J.V = J.K0 + 4096; J.vs = 8192; J.tiled = 1;
        J.O = Ob + (size_t)(b * SEQ + qb * 256) * os + ocol + h * 64; J.os = os; J.LSE = nullptr; J.lses = 0; J.q0 = 0; J.kt_lo = 0; J.kt_hi = MEML / 64;
#if ATT_PIPE == 1
        attn_unit_pipe<4>(J, lds); }
#elif ATT_PIPE == 2
        attn_unit2<4>(J, lds); }
#elif ATT_PIPE == 3
        attn_unit_d2<4>(J, lds); }
#else
        attn_unit<4, false, false>(J, lds); }
#endif
}
__device__ __forceinline__ void attn0_phase(unsigned char* ws, LAS unsigned char* lds, int vcu, int G) {
    const bf16_t* PROJ = (const bf16_t*)(ws + WS_PROJ); bf16_t* OG = (bf16_t*)(ws + WS_OG); float* LSE = (float*)(ws + WS_LSE);
    const int upw = (3072 + G - 1) / G;
    for (int i = 0; i < upw; ++i) { const int u = vcu * upw + i; if (u >= 3072) break;
        const int g = u >> 10, rem = u & 1023, j = rem & 3, rest = rem >> 2;
        const int dil = 1 << (2 * g), T = SEQ / dil, nqb = T / 256, n = rest / nqb, qb = rest % nqb, b = n / dil, r = n % dil;
        const size_t tok0 = (size_t)b * SEQ + r, tokq = tok0 + (size_t)dil * qb * 256; const int hc = (g * 4 + j) * 64;
        AttnJob J; J.Q = PROJ + tokq * A_IN + hc; J.qs = dil * A_IN;
        J.K0 = PROJ + tok0 * A_IN + 768 + hc; J.k0s = dil * A_IN; J.K1 = J.K0; J.k1s = J.k0s; J.V = PROJ + tok0 * A_IN + 1536 + hc; J.vs = dil * A_IN;
        J.O = OG + (size_t)g * NTOK * 256 + tokq * 256 + j * 64; J.os = dil * 256;
        J.LSE = LSE + (size_t)g * NTOK * 4 + tokq * 4 + j; J.lses = dil * 4;
        J.tiled = 0; J.q0 = qb * 256; J.kt_lo = (qb * 4 - 1 > 0) ? qb * 4 - 1 : 0; J.kt_hi = (qb * 4 + 5 < T / 64) ? qb * 4 + 5 : T / 64;
        attn_unit<4, true, true>(J, lds); }
    mem_attn_units(PROJ, A_IN, 2304, (const bf16_t*)(ws + WS_MEMKV), 0, (bf16_t*)(ws + WS_CAT), 512, 256, lds, vcu, G);
}
__device__ __forceinline__ void attn1_phase(unsigned char* ws, LAS unsigned char* lds, int vcu, int G) {
    const bf16_t* QBp = (const bf16_t*)(ws + WS_QB); const bf16_t* KVp = (const bf16_t*)(ws + WS_KV); const bf16_t* PB = (const bf16_t*)(ws + WS_PROJB); bf16_t* ATT = (bf16_t*)(ws + WS_ATT);
    const int upw = (2048 + G - 1) / G;
    for (int i = 0; i < upw; ++i) {
        int bh, qb;
        if (G == 256) { const int x = vcu >> 5, w = vcu & 31; bh = x * 16 + 2 * i + (w >> 4); qb = w & 15; }
        else { const int u = vcu * upw + i; if (u >= 2048) break; bh = u >> 4; qb = u & 15; }
        const int b = bh >> 3, h = bh & 7;
        AttnJob J; J.Q = QBp + (size_t)(b * SEQ + qb * 256) * 768 + h * 96; J.qs = 768;
        J.K0 = KVp + (size_t)(b * 8 + h) * 64 * 8192; J.k0s = 8192; J.K1 = (const bf16_t*)(ws + WS_KPE) + (size_t)b * 64 * 2048; J.k1s = 2048; J.V = J.K0 + 4096; J.vs = 8192; J.tiled = 1;
        J.O = ATT + (size_t)(b * SEQ + qb * 256) * 768 + h * 64; J.os = 768; J.LSE = nullptr; J.lses = 0; J.q0 = qb * 256; J.kt_lo = 0; J.kt_hi = SEQ / 64;
#if ATT_PIPE == 1
        attn_unit_pipe<6>(J, lds); }
#elif ATT_PIPE == 2
        attn_unit2<6>(J, lds); }
#elif ATT_PIPE == 3
        attn_unit_d2<6>(J, lds); }
#else
        attn_unit<6, false, false>(J, lds); }
#endif
    mem_attn_units(PB, B_INP, 416, (const bf16_t*)(ws + WS_MEMKV), 1, ATT, 768, 512, lds, vcu, G);
}

constexpr int NPH = 21;
struct Args { const float* in[22]; float* out; unsigned char* ws; int ph_lo, ph_hi; };
__device__ __forceinline__ DenseProb dense(const void* A, unsigned lda_el, const void* Bt, unsigned ldb_el, int M, int N, int K, int G) {
    DenseProb p; p.Abase = (const char*)A; p.lda_bytes = lda_el * 2u; p.Bt = (const char*)Bt; p.ldb_bytes = ldb_el * 2u; p.K = K; p.nM = M / 256; p.nN = N / 256; p.G = G; p.c = (int)blockIdx.x; p.delay = 0; return p; }

__global__ void __launch_bounds__(NTHREADS, 2) fwd(Args args) {
    extern __shared__ __attribute__((aligned(16))) unsigned char lds_raw[];
    LAS unsigned char* lds = (LAS unsigned char*)lds_raw;
    const int tid = threadIdx.x, lane = tid & 63, wave = __builtin_amdgcn_readfirstlane(tid >> 6);
    const int G = gridDim.x; const int bx = blockIdx.x; const int vcu = (G % 8 == 0) ? (bx % 8) * (G / 8) + bx / 8 : bx;
    const int gw = vcu * NWAVES + wave, NGW = G * NWAVES;
    unsigned char* ws = args.ws;
    unsigned* ctl = (unsigned*)(ws + WS_CTL);
    for (int u = tid; u < (LDS_BYTES - MISC_OFF) / 4; u += NTHREADS) ((LAS unsigned*)(lds + MISC_OFF))[u] = 0u;
    __syncthreads();
#if MK_N_LAUNCHES == 1
    XcdBarrier bar = xcd_barrier_post(ctl + CW_BAR, (volatile LAS unsigned*)(lds + MISC_OFF));
#define GRID_BAR() xcd_barrier(bar)
#else
#define GRID_BAR() do {} while (0)
#endif
    const int lo = args.ph_lo, hi = args.ph_hi;
#define IN(k) (lo <= (k) && (k) < hi)
#define SEAM(k) do { if (IN(k) && IN((k) + 1)) GRID_BAR(); } while (0)
    bf16_t* X = (bf16_t*)(ws + WS_X);

#ifndef DESYNC
#define DESYNC 0
#endif
#ifndef DBL_MASK
#define DBL_MASK 0
#endif
#define PHASE(k, ...) do { if (IN(k)) { _Pragma("unroll") for (int _r = 0; _r < (((DBL_MASK >> (k)) & 1) ? 2 : 1); ++_r) { if (_r) GRID_BAR(); __VA_ARGS__ } } SEAM(k); } while (0)
    PHASE(0, {
        ProIn I; I.x = args.in[0]; I.mem = args.in[1]; I.a_w_in = args.in[2]; I.a_w_out = args.in[3]; I.b_w_in = args.in[4]; I.b_q_norm = args.in[5]; I.b_w_qb = args.in[6];
        I.b_kv_norm = args.in[7]; I.b_w_kvb = args.in[8]; I.b_w_out = args.in[9]; I.mem_w_kv = args.in[10]; I.w_grp = args.in[15]; I.w_exp = args.in[17];
        I.w_gate = args.in[19]; I.w_up = args.in[20]; I.w_down = args.in[21];
        prologue_phase(I, ws, lds, gw, NGW, lane); });
    PHASE(1, {
        { DenseProb P = dense(X, DM, ws + WS_WINA, DM, NTOK, A_IN, DM, G); P.delay = DESYNC ? ((bx >> 6) & 3) * 870 : 0; const EpiProjA E{(bf16_t*)(ws + WS_PROJ), (const f32x2*)(ws + WS_ROPEA)}; pg::gemm_phase(lds, P, E); }
        { const DenseProb P = dense(ws + WS_MEMB, DM, ws + WS_WMEM, DM, NMEM, 1024, DM, G); const EpiMemKV E{(bf16_t*)(ws + WS_MEMKV)}; pg::gemm_phase(lds, P, E); } });
    PHASE(2, { attn0_phase(ws, lds, vcu, G); });
    PHASE(3, { merge_phase(ws, gw, NGW, lane); });
    PHASE(4, { const DenseProb P = dense(ws + WS_CAT, 512, ws + WS_WOUTA, 512, NTOK, DM, 512, G); const EpiPlain E{(bf16_t*)(ws + WS_Y), DM}; pg::gemm_phase(lds, P, E); });
#define MOE_BLOCK(PH, LAYER, FINAL) \
    PHASE((PH) - 1, { ln_mix_phase(ws, args.in[11] + (LAYER) * DM, args.in[12] + (LAYER) * DM, gw, NGW, lane); }); \
    PHASE(PH, { router_phase(ws, (const bf16_t*)(ws + WS_WR) + (size_t)(LAYER) * 48 * 1024, args.in[16] + (LAYER) * 4, args.in[18] + (LAYER) * 32, lds, vcu, G, wave, lane); }); \
    PHASE((PH) + 1, { assign_phase(ws, lds, vcu, G, wave, lane); }); \
    PHASE((PH) + 2, { \
        if (tid <= NEXP) ((LAS int*)(lds + MISC_TSTART))[tid] = ((const int*)(ws + WS_META))[tid]; \
        __syncthreads(); \
        MoeProb P; P.Abase = (const char*)(ws + WS_XB); P.lda_bytes = DM * 2; P.Bt = (const char*)(ws + WS_WGU) + (size_t)(LAYER) * 32 * 1024 * 1024 * 2; P.bexp_bytes = (size_t)1024 * 1024 * 2; P.ldb_bytes = 2048; \
        P.K = DM; P.nM = __builtin_amdgcn_readfirstlane(((LAS int*)(lds + MISC_TSTART))[NEXP]); P.nN = 4; P.G = G; P.c = bx; P.slot_tok = (const int*)(ws + WS_SLOTTOK); P.tstart = (const LAS int*)(lds + MISC_TSTART); P.delay = DESYNC ? ((bx >> 6) & 3) * 830 : 0; \
        const EpiGateUp E{(bf16_t*)(ws + WS_H)}; pg::gemm_phase(lds, P, E); }); \
    PHASE((PH) + 3, { \
        if (tid <= NEXP) ((LAS int*)(lds + MISC_TSTART))[tid] = ((const int*)(ws + WS_META))[tid]; \
        __syncthreads(); \
        MoeProb P; P.Abase = (const char*)(ws + WS_H); P.lda_bytes = DEXP * 2; P.Bt = (const char*)(ws + WS_WD) + (size_t)(LAYER) * 32 * 1024 * 512 * 2; P.bexp_bytes = (size_t)1024 * 512 * 2; P.ldb_bytes = 1024; \
        P.K = DEXP; P.nM = __builtin_amdgcn_readfirstlane(((LAS int*)(lds + MISC_TSTART))[NEXP]); P.nN = 4; P.G = G; P.c = bx; P.slot_tok = nullptr; P.tstart = (const LAS int*)(lds + MISC_TSTART); P.delay = DESYNC ? ((bx >> 6) & 3) * 575 : 0; \
        const EpiPlain E{(bf16_t*)(ws + WS_YS), DM}; pg::gemm_phase(lds, P, E); }); \
    PHASE((PH) + 4, { ln_moe_phase<FINAL>(ws, args.in[13] + (LAYER) * DM, args.in[14] + (LAYER) * DM, args.out, gw, NGW, lane); });
    MOE_BLOCK(6, 0, false)
    PHASE(11, { const DenseProb P = dense(X, DM, ws + WS_WINB, DM, NTOK, B_INP, DM, G); const EpiProjB E{(bf16_t*)(ws + WS_PROJB), (const f32x2*)(ws + WS_ROPEB), (float*)(ws + WS_RQ), (float*)(ws + WS_RKV), (bf16_t*)(ws + WS_KPE)}; pg::gemm_phase(lds, P, E); });
    PHASE(12, {
        { const DenseProb P = dense(ws + WS_PROJB, B_INP, ws + WS_WQB, 256, NTOK, 768, 256, G); const EpiQ E{(bf16_t*)(ws + WS_QB), (const f32x2*)(ws + WS_ROPEB), (const float*)(ws + WS_RQ)}; pg::gemm_phase(lds, P, E); }
        { const DenseProb P = dense((const bf16_t*)(ws + WS_PROJB) + 128, B_INP, ws + WS_WKVB, 256, NTOK, 1024, 256, G); const EpiKV E{(bf16_t*)(ws + WS_KV), (const float*)(ws + WS_RKV)}; pg::gemm_phase(lds, P, E); } });
    PHASE(13, { attn1_phase(ws, lds, vcu, G); });
    PHASE(14, { const DenseProb P = dense(ws + WS_ATT, 768, ws + WS_WOUTB, 768, NTOK, DM, 768, G); const EpiPlain E{(bf16_t*)(ws + WS_Y), DM}; pg::gemm_phase(lds, P, E); });
    MOE_BLOCK(16, 1, true)
#undef IN
#undef SEAM
}


#ifndef DIAG
#define DIAG 0
#endif
#if DIAG
__global__ void ck_kernel(const unsigned* p, size_t nwords, const int* meta, int rowwords, unsigned long long* out) {
    if (meta) nwords = (size_t)meta[32] * 256 * rowwords;
    unsigned long long a = 0, b = 0;
    for (size_t i = (size_t)blockIdx.x * blockDim.x + threadIdx.x; i < nwords; i += (size_t)gridDim.x * blockDim.x) { const unsigned w = p[i]; a += w; b += (unsigned)(w * 2654435761u) >> 5; }
    for (int o = 32; o >= 1; o >>= 1) { a += __shfl_xor(a, o); b += __shfl_xor(b, o); }
    if ((threadIdx.x & 63) == 0) { atomicAdd(out, a); atomicAdd(out + 1, b); }
}
__global__ void cmp_rows_kernel(const unsigned short* a, const unsigned short* b, unsigned long long* out) {
    const int lane = threadIdx.x & 63; const size_t w = ((size_t)blockIdx.x * blockDim.x + threadIdx.x) >> 6, nw = ((size_t)gridDim.x * blockDim.x) >> 6;
    unsigned long long nr = 0, ne = 0;
    for (size_t row = w; row < (size_t)NTOK; row += nw) { int d = 0; for (int i = lane; i < DM; i += 64) d += a[row * DM + i] != b[row * DM + i];
        for (int o = 32; o >= 1; o >>= 1) d += __shfl_xor(d, o);
        if (d) { nr += 1; ne += d; } }
    if (lane == 0) { atomicAdd(out, nr); atomicAdd(out + 1, ne); }
}
__global__ void enc_kernel(const unsigned long long* sums, float* out, size_t n) {
    int first = -1;
    for (int p = 0; p < 32; ++p) { bool d = false; for (int rep = 1; rep < 3; ++rep) d = d || sums[p * 2] != sums[(rep * 32 + p) * 2] || sums[p * 2 + 1] != sums[(rep * 32 + p) * 2 + 1]; if (d) { first = p; break; } }
    if (first < 0) return;
    const float c = (float)(first + 2);
    for (size_t i = (size_t)blockIdx.x * blockDim.x + threadIdx.x; i < n; i += (size_t)gridDim.x * blockDim.x) out[i] = c;
}
#endif

extern "C" void kernel_launch(void* const* d_in, const int* in_sizes, int n_in, void* d_out, int out_size, void* d_ws, size_t ws_size, hipStream_t stream) {
    static int grid = 0;
    if (grid == 0) {
        if (n_in != 22 || in_sizes[0] != NTOK * DM || out_size != NTOK * DM || ws_size < WS_END) { fprintf(stderr, "kernel_launch: unexpected shapes (n_in %d, ws %zu)\n", n_in, ws_size); grid = -1; return; }
        int dev = 0, cus = 0, per_cu = 0;
        if (hipGetDevice(&dev) != hipSuccess || hipDeviceGetAttribute(&cus, hipDeviceAttributeMultiprocessorCount, dev) != hipSuccess) { grid = -1; return; }
        if (hipFuncSetAttribute((const void*)fwd, hipFuncAttributeMaxDynamicSharedMemorySize, LDS_BYTES) != hipSuccess) { fprintf(stderr, "kernel_launch: hipFuncSetAttribute failed\n"); grid = -1; return; }
        if (hipOccupancyMaxActiveBlocksPerMultiprocessor(&per_cu, (const void*)fwd, NTHREADS, LDS_BYTES) != hipSuccess || per_cu < 1) fprintf(stderr, "kernel_launch: occupancy query says %d\n", per_cu);
        (void)hipGetLastError();
        grid = cus;
    }
    if (grid < 0) return;
    (void)hipMemsetAsync((char*)d_ws + WS_CTL, 0, CTL_ZERO_BYTES, stream);
    Args a{};
    for (int i = 0; i < 22; ++i) a.in[i] = (const float*)d_in[i];
    a.out = (float*)d_out; a.ws = (unsigned char*)d_ws;
#if MK_N_LAUNCHES == 1
    a.ph_lo = 0; a.ph_hi = NPH;
    hipLaunchKernelGGL(fwd, dim3(grid), dim3(NTHREADS), LDS_BYTES, stream, a);
#else
#if DIAG
    unsigned char* ws = (unsigned char*)d_ws; unsigned long long* sums = (unsigned long long*)(ws + WS_CTL + 512 * 1024);
    const int* meta = (const int*)(ws + WS_META);
    (void)hipMemsetAsync(ws + MiB, 0xAA, WS_END - MiB, stream);
#define CK(off, bytes) hipLaunchKernelGGL(ck_kernel, dim3(1024), dim3(256), 0, stream, (const unsigned*)(ws + (off)), (size_t)(bytes) / 4, (const int*)nullptr, 0, sums + (rep * 32 + p) * 2)
#define CKM(off, rowwords) hipLaunchKernelGGL(ck_kernel, dim3(1024), dim3(256), 0, stream, (const unsigned*)(ws + (off)), (size_t)0, meta, (rowwords), sums + (rep * 32 + p) * 2)
    for (int p = 0; p < NPH; ++p) {
        for (int rep = 0; rep < 3; ++rep) {
            a.ph_lo = p; a.ph_hi = p + 1; hipLaunchKernelGGL(fwd, dim3(grid), dim3(NTHREADS), LDS_BYTES, stream, a);
            switch (p) {
            case 0: CK(WS_WINA, 7 * MiB + 896 * 1024); CK(WS_WKVB, 4 * MiB); CK(WS_WR, 192 * 1024); CK(WS_WGU, 192 * MiB); CK(WS_MEMB, 8 * MiB); CK(WS_X, 128 * MiB); CK(WS_ROPEA, 768 * 1024); break;
            case 1: CK(WS_PROJ, 320 * MiB); CK(WS_MEMKV, 8 * MiB); break;
            case 2: CK(WS_OG, 96 * MiB); CK(WS_LSE, 3 * MiB); CK(WS_CAT, 64 * MiB); break;
            case 3: CK(WS_CAT, 64 * MiB); break;
            case 4: case 14: CK(WS_Y, 128 * MiB); break;
            case 5: case 15: CK(WS_XB, 128 * MiB); break;
            case 6: case 16: CK(WS_TOKGW, 1024 * 1024); CK(WS_WGCNT, 32 * 1024); break;
            case 7: case 17: CK(WS_META, 512); break;
            case 8: case 18: CKM(WS_H, 256); break;
            case 9: case 19: CKM(WS_YS, 512); break;
            case 10: CK(WS_X, 128 * MiB); break;
            case 11: CK(WS_PROJB, 96 * MiB); CK(WS_RQ, 2 * MiB); break;
            case 12: CK(WS_QB, 96 * MiB); CK(WS_KV, 128 * MiB); break;
            case 13: CK(WS_ATT, 96 * MiB); break;
            default: hipLaunchKernelGGL(ck_kernel, dim3(1024), dim3(256), 0, stream, (const unsigned*)d_out, (size_t)NTOK * DM, (const int*)nullptr, 0, sums + (rep * 32 + p) * 2); break; } } }
    hipLaunchKernelGGL(enc_kernel, dim3(1024), dim3(256), 0, stream, (const unsigned long long*)sums, (float*)d_out, (size_t)NTOK * DM);
#else
    for (int p = 0; p < NPH; ++p) { a.ph_lo = p; a.ph_hi = p + 1; hipLaunchKernelGGL(fwd, dim3(grid), dim3(NTHREADS), LDS_BYTES, stream, a); }
#endif
#endif
}
```
